# Optimizing an MI355X kernel written in HIP

```python
import math
import jax, jax.numpy as jnp
from jax import lax
import numpy as np

D_MODEL = 1024
BATCH = 8
SEQ = 2048
DEPTH = 4
DEC_BATCH = 128
DEC_SEQ = 4
PAST_LEN = 8192
PAGE_SIZE = 128

MIX_WIDTH = D_MODEL
A_WIDTH = MIX_WIDTH // 2
B_WIDTH = MIX_WIDTH - A_WIDTH
H_A = 4
DK_A = A_WIDTH // H_A
DV_A = A_WIDTH // H_A
CONV_WIDTH = 4
CONV_DIM = 2 * H_A * DK_A + H_A * DV_A
CHUNK = 64
HD_B = 64
H_QB = B_WIDTH // HD_B
H_KVB = 2
GQA_GROUP = H_QB // H_KVB
WINDOW = 128
D_FF = -(-8 * D_MODEL // (3 * 256)) * 256
ALPHA = (2 * DEPTH) ** 0.25
BETA_INIT = (8 * DEPTH) ** -0.25
EPS = 1e-6
PROJ_SIZES = (CONV_DIM, H_A * DV_A, H_A, H_A, H_QB * HD_B, H_KVB * HD_B, H_KVB * HD_B)
PROJ_SPLITS = tuple(int(s) for s in np.cumsum(PROJ_SIZES)[:-1])
PROJ_WIDTH = int(sum(PROJ_SIZES))

kernel_name = "hymba_gdn_swa_sink_deepnorm_step"


def layernorm(x, g, b):
    xf = x.astype(jnp.float32)
    mu = xf.mean(-1, keepdims=True)
    var = jnp.square(xf - mu).mean(-1, keepdims=True)
    return ((xf - mu) * lax.rsqrt(var + EPS) * g.astype(jnp.float32) + b.astype(jnp.float32)).astype(x.dtype)


def l2norm(t):
    return t * lax.rsqrt(jnp.sum(t * t, axis=-1, keepdims=True) + EPS)


def rmsnorm_gated(o, w, z):
    of = o.astype(jnp.float32)
    of = of * lax.rsqrt(jnp.mean(of * of, axis=-1, keepdims=True) + EPS) * w.astype(jnp.float32)
    return (of * jax.nn.silu(z.astype(jnp.float32))).astype(z.dtype)


def causal_conv(x, buf, w):
    L = x.shape[1]
    xc = jnp.concatenate([buf, x], axis=1)
    y = xc[:, 0:L] * w[0]
    for j in range(1, CONV_WIDTH):
        y = y + xc[:, j:j + L] * w[j]
    return jax.nn.silu(y), xc[:, -(CONV_WIDTH - 1):]


def gated_delta_rule(q, k, v, g, beta, S0):
    Bn, L, H, DK = q.shape
    DV = v.shape[-1]
    C = math.gcd(L, CHUNK)
    N = L // C

    def chunks(t):
        t = t.reshape((Bn, N, C, H) + t.shape[3:])
        return jnp.swapaxes(t, 2, 3)

    qc, kc, vc, gc_, bc = chunks(q), chunks(k), chunks(v), chunks(g), chunks(beta)
    gc = jnp.cumsum(gc_, axis=-1)
    ii = jnp.arange(C)[:, None]
    jj = jnp.arange(C)[None, :]
    causal = ii >= jj
    strict = ii > jj
    decay = jnp.exp(jnp.where(causal, gc[..., :, None] - gc[..., None, :], -jnp.inf))
    kb = kc * bc[..., None]
    A = jnp.where(strict, jnp.einsum('bnhid,bnhjd->bnhij', kb, kc) * decay, 0.0)
    M = A + jnp.eye(C, dtype=A.dtype)
    rhs = jnp.concatenate([vc * bc[..., None], kb * jnp.exp(gc)[..., None]], axis=-1)
    sol = lax.linalg.triangular_solve(M, rhs, left_side=True, lower=True, unit_diagonal=True)
    u, w = sol[..., :DV], sol[..., DV:]
    qk = jnp.einsum('bnhid,bnhjd->bnhij', qc, kc) * decay
    q_dec = qc * jnp.exp(gc)[..., None]
    k_dec = kc * jnp.exp(gc[..., -1:] - gc)[..., None]
    g_last = jnp.exp(gc[..., -1])

    def step(S, inp):
        u_n, w_n, qk_n, qd_n, kd_n, gl_n = inp
        v_new = u_n - jnp.einsum('bhcd,bhde->bhce', w_n, S)
        o_n = jnp.einsum('bhcd,bhde->bhce', qd_n, S) + jnp.einsum('bhij,bhje->bhie', qk_n, v_new)
        S = S * gl_n[..., None, None] + jnp.einsum('bhcd,bhce->bhde', kd_n, v_new)
        return S, o_n

    xs = tuple(jnp.moveaxis(t, 1, 0) for t in (u, w, qk, q_dec, k_dec, g_last))
    S_final, o = lax.scan(step, S0, xs)
    o = jnp.transpose(o, (1, 0, 3, 2, 4)).reshape(Bn, L, H, DV)
    return o, S_final


def swa_sinks(q, k, v, k_pre, v_pre, prefix_len, sinks):
    Bn, L = q.shape[:2]
    QB = math.gcd(L, WINDOW)
    N = L // QB
    KB = WINDOW + QB
    k_ext = jnp.concatenate([k_pre, k], axis=1)
    v_ext = jnp.concatenate([v_pre, v], axis=1)
    idx = jnp.arange(N)[:, None] * QB + jnp.arange(KB)[None, :]
    kbk = k_ext[:, idx]
    vbk = v_ext[:, idx]
    qb = q.reshape(Bn, N, QB, H_KVB, GQA_GROUP, HD_B)
    s = jnp.einsum('bnqhgd,bnkhd->bnhgqk', qb, kbk).astype(jnp.float32) * (HD_B ** -0.5)
    r = jnp.arange(QB)[:, None]
    c = jnp.arange(KB)[None, :]
    band = (c > r) & (c <= r + WINDOW)
    mask = band[None] & (idx >= WINDOW - prefix_len)[:, None, :]
    s = jnp.where(mask[None, :, None, None], s, -jnp.inf)
    sink = jnp.broadcast_to(sinks.astype(jnp.float32).reshape(1, 1, H_KVB, GQA_GROUP, 1, 1),
                            s.shape[:-1] + (1,))
    p = jax.nn.softmax(jnp.concatenate([s, sink], axis=-1), axis=-1)[..., :KB]
    o = jnp.einsum('bnhgqk,bnkhd->bnqhgd', p.astype(v.dtype), vbk).reshape(Bn, L, H_QB * HD_B)
    return o, k_ext[:, -WINDOW:], v_ext[:, -WINDOW:]


def token_mix(h, S0, conv_buf, k_pre, v_pre, prefix_len,
              w_in, conv_w, a_log, dt_bias, norm_a_w, sinks, w_out):
    Bn, L, _ = h.shape
    proj = jnp.einsum('bld,dp->blp', h, w_in)
    qkv_a, z_a, b_a, a_a, q_b, k_b, v_b = jnp.split(proj, PROJ_SPLITS, axis=-1)
    qkv_c, new_conv = causal_conv(qkv_a, conv_buf, conv_w)
    qc, kc, vc = jnp.split(qkv_c.astype(jnp.float32), (H_A * DK_A, 2 * H_A * DK_A), axis=-1)
    q = l2norm(qc.reshape(Bn, L, H_A, DK_A)) * (DK_A ** -0.5)
    k = l2norm(kc.reshape(Bn, L, H_A, DK_A))
    v = vc.reshape(Bn, L, H_A, DV_A)
    beta = jax.nn.sigmoid(b_a.astype(jnp.float32))
    g = -jnp.exp(a_log.astype(jnp.float32)) * jax.nn.softplus(a_a.astype(jnp.float32) + dt_bias.astype(jnp.float32))
    o_a, S_new = gated_delta_rule(q, k, v, g, beta, S0.astype(jnp.float32))
    o_a = rmsnorm_gated(o_a, norm_a_w, z_a.reshape(Bn, L, H_A, DV_A))
    o_b, k_new, v_new = swa_sinks(q_b.reshape(Bn, L, H_QB, HD_B), k_b.reshape(Bn, L, H_KVB, HD_B),
                                  v_b.reshape(Bn, L, H_KVB, HD_B), k_pre, v_pre, prefix_len, sinks)
    mixed = jnp.concatenate([o_a.reshape(Bn, L, A_WIDTH).astype(h.dtype), o_b.astype(h.dtype)], axis=-1)
    out = jnp.einsum('blm,md->bld', mixed, w_out)
    return out, S_new.astype(S0.dtype), new_conv, k_new, v_new


def swiglu(h, w_ffn_in, w_ffn_out):
    gate, up = jnp.split(jnp.einsum('bld,df->blf', h, w_ffn_in), 2, axis=-1)
    return jnp.einsum('blf,fd->bld', jax.nn.silu(gate) * up, w_ffn_out)


def setup_inputs(seed: int = 0) -> dict:
    key = jax.random.key(seed)
    ks = jax.random.split(key, 20)
    f32 = jnp.float32

    def nrm(k, shape, s):
        return jax.random.normal(k, shape, f32) * s

    swa_len = min(WINDOW, PAST_LEN)
    dt = jnp.exp(jax.random.uniform(ks[8], (DEPTH, H_A), f32, math.log(1e-3), math.log(1e-1)))
    return {
        "x_prompt": nrm(ks[0], (BATCH, SEQ, D_MODEL), 1.0),
        "x_sample": nrm(ks[1], (DEC_BATCH, DEC_SEQ, D_MODEL), 1.0),
        "state_delta": nrm(ks[2], (DEPTH, DEC_BATCH, H_A, DK_A, DV_A), 0.1),
        "state_conv": nrm(ks[3], (DEPTH, DEC_BATCH, CONV_WIDTH - 1, CONV_DIM), 1.0),
        "cache_swa_k": nrm(ks[4], (DEPTH, DEC_BATCH, swa_len, H_KVB, HD_B), 1.0),
        "cache_swa_v": nrm(ks[5], (DEPTH, DEC_BATCH, swa_len, H_KVB, HD_B), 1.0),
        "w_in": nrm(ks[6], (DEPTH, D_MODEL, PROJ_WIDTH), D_MODEL ** -0.5),
        "conv_w": nrm(ks[7], (DEPTH, CONV_WIDTH, CONV_DIM), CONV_WIDTH ** -0.5),
        "a_log": jnp.log(jax.random.uniform(ks[9], (DEPTH, H_A), f32, 1.0, 16.0)),
        "dt_bias": dt + jnp.log(-jnp.expm1(-dt)),
        "norm_a_w": 1.0 + nrm(ks[10], (DEPTH, DV_A), 0.02),
        "sinks": nrm(ks[11], (DEPTH, H_QB), 1.0),
        "w_out": nrm(ks[12], (DEPTH, MIX_WIDTH, D_MODEL), BETA_INIT * MIX_WIDTH ** -0.5),
        "ln1_g": 1.0 + nrm(ks[13], (DEPTH, D_MODEL), 0.02),
        "ln1_b": nrm(ks[14], (DEPTH, D_MODEL), 0.02),
        "w_ffn_in": nrm(ks[15], (DEPTH, D_MODEL, 2 * D_FF), D_MODEL ** -0.5),
        "w_ffn_out": nrm(ks[16], (DEPTH, D_FF, D_MODEL), BETA_INIT * D_FF ** -0.5),
        "ln2_g": 1.0 + nrm(ks[17], (DEPTH, D_MODEL), 0.02),
        "ln2_b": nrm(ks[18], (DEPTH, D_MODEL), 0.02),
    }


def reference(x_prompt, x_sample, state_delta, state_conv, cache_swa_k, cache_swa_v,
              w_in, conv_w, a_log, dt_bias, norm_a_w, sinks, w_out,
              ln1_g, ln1_b, w_ffn_in, w_ffn_out, ln2_g, ln2_b):
    xp, xs = x_prompt, x_sample
    Bp = xp.shape[0]
    dt_ = xp.dtype
    S_zero = jnp.zeros((Bp, H_A, DK_A, DV_A), state_delta.dtype)
    conv_zero = jnp.zeros((Bp, CONV_WIDTH - 1, CONV_DIM), dt_)
    kv_zero = jnp.zeros((Bp, WINDOW, H_KVB, HD_B), dt_)
    sample_prefix = cache_swa_k.shape[2]
    Sp, Cp, Kp, Vp, Ss, Cs, Ks, Vs = [], [], [], [], [], [], [], []
    for l in range(DEPTH):
        lw = (w_in[l], conv_w[l], a_log[l], dt_bias[l], norm_a_w[l], sinks[l], w_out[l])
        mp, s1, c1, k1, v1 = token_mix(xp, S_zero, conv_zero, kv_zero, kv_zero, 0, *lw)
        xp = layernorm(ALPHA * xp + mp, ln1_g[l], ln1_b[l])
        xp = layernorm(ALPHA * xp + swiglu(xp, w_ffn_in[l], w_ffn_out[l]), ln2_g[l], ln2_b[l])
        ms, s2, c2, k2, v2 = token_mix(xs, state_delta[l], state_conv[l], cache_swa_k[l], cache_swa_v[l],
                                       sample_prefix, *lw)
        xs = layernorm(ALPHA * xs + ms, ln1_g[l], ln1_b[l])
        xs = layernorm(ALPHA * xs + swiglu(xs, w_ffn_in[l], w_ffn_out[l]), ln2_g[l], ln2_b[l])
        Sp.append(s1); Cp.append(c1); Kp.append(k1); Vp.append(v1)
        Ss.append(s2); Cs.append(c2); Ks.append(k2); Vs.append(v2)
    new_delta_p = jnp.stack(Sp)
    new_conv_p = jnp.stack(Cp)
    new_swa_k_p = jnp.stack(Kp)
    new_swa_v_p = jnp.stack(Vp)
    new_delta_s = jnp.stack(Ss)
    new_conv_s = jnp.stack(Cs)
    new_swa_k_s = jnp.stack(Ks)
    new_swa_v_s = jnp.stack(Vs)
    return (xp, xs, new_delta_p, new_conv_p, new_swa_k_p, new_swa_v_p,
            new_delta_s, new_conv_s, new_swa_k_s, new_swa_v_s)
```

```cpp
#include <hip/hip_runtime.h>
#include <hip/hip_cooperative_groups.h>
#include <cstdio>
#include <cstdint>
namespace pg8 {
#define PG8_LAS __attribute__((address_space(3)))
typedef unsigned short bf16_t;
typedef short bf16x8 __attribute__((ext_vector_type(8)));
typedef float f32x4 __attribute__((ext_vector_type(4)));
typedef unsigned u32x4 __attribute__((ext_vector_type(4)));
constexpr int BM = 256, BK = 64, HALF = 128, HTB = HALF * BK * 2  , STAGE_BYTES = 8 * HTB, NXCD = 8, WGM = 8;

__host__ __device__ __forceinline__ int lds_byte(int r, int c) { const int st = (r >> 4) * 2 + (c >> 5), rr = r & 15, cc = c & 31, ob = rr * 64 + cc * 2; return st * 1024 + (ob ^ (((ob >> 9) & 1) << 5)); }
__host__ __device__ __forceinline__ void stage_rc(int b, int& R, int& C) { const int st = b / 1024, sb = b % 1024, swz = sb ^ (((sb >> 9) & 1) << 5); R = (st >> 1) * 16 + swz / 64; C = (st & 1) * 32 + (swz % 64) / 2; }
__host__ __device__ __forceinline__ int perm32(int rho) { const int n = rho >> 4, i = rho & 15; return 8 * (i >> 2) + 4 * n + (i & 3); }

struct Unit { int pm, pn; };
struct Gemm { const bf16_t* A; const bf16_t* Bt; int M, N, K; };

struct StaticOrder {
    int nM, nN, nwg, G, c;
    __host__ __device__ void init(int M, int N, int G_, int c_) { nM = M / BM; nN = N / BM; nwg = nM * nN; G = G_; c = c_; }
    __host__ __device__ bool next(int i, Unit& u) const {
        const long L = (long)i * G + c; if (L >= nwg) return false;
        int wgid = (int)L; { const int q = nwg / NXCD, r = nwg % NXCD, xcd = wgid % NXCD, off = wgid / NXCD; wgid = (xcd < r ? xcd * (q + 1) : r * (q + 1) + (xcd - r) * q) + off; }
        const int nig = WGM * nN, gid = wgid / nig, fm = gid * WGM, gsz = (nM - fm) < WGM ? (nM - fm) : WGM;
        u.pm = fm + ((wgid % nig) % gsz); u.pn = (wgid % nig) / gsz; return true;
    }
    __device__ __forceinline__ void a_ready(const Unit&) const {}
    __device__ __forceinline__ void done(const Unit&) const {}
};

__device__ __forceinline__ unsigned cvt_pk_bf16(float lo, float hi) { unsigned r; asm volatile("v_cvt_pk_bf16_f32 %0, %1, %2" : "=v"(r) : "v"(lo), "v"(hi)); return r; }
typedef float f32x2 __attribute__((ext_vector_type(2)));
__device__ __forceinline__ f32x2 gelu_pk(f32x2 v) {
    const f32x2 av = __builtin_elementwise_abs(v), d = av * 0.2316418882f + 1.0f;
    f32x2 t; t.x = __builtin_amdgcn_rcpf(d.x); t.y = __builtin_amdgcn_rcpf(d.y);
    f32x2 q = t * 0.5307027145f + (-0.7265760135f); q = q * t + 0.7107068705f; q = q * t + (-0.142248368f); q = q * t + 0.127414796f; q = q * t;
    const f32x2 s = (v * v) * (-0.72134752044f);
    f32x2 e; e.x = __builtin_amdgcn_exp2f(s.x); e.y = __builtin_amdgcn_exp2f(s.y);
    const f32x2 m = v * (q * e), r = v - m;
    f32x2 o; o.x = v.x < 0.f ? m.x : r.x; o.y = v.y < 0.f ? m.y : r.y; return o;
}

template <int ACT  > struct EpiBf16 {
    static constexpr bool PERM = true, AFTER_DRAIN = false; static_assert(ACT == 0 || ACT == 1, "EpiBf16: ACT is 0 (none) or 1 (gelu_pk)");
    bf16_t* O; int ldc; const float* bias; int split_cols; size_t split_stride; float scale0;
    __device__ __forceinline__ void operator()(const f32x4 (&acc)[2][2][4][2], const Unit& u, int wr, int wc, int fr, int fq) const {
        const int row0 = u.pm * BM + wr * 64 + fr; int colt = u.pn * BM; bf16_t* base = O;
        float sc = 1.f; if (split_cols) { const int t = colt / split_cols; base += (size_t)t * split_stride; colt -= t * split_cols; if (t == 0) sc = scale0; }
        const int col0 = colt + wc * 32 + 8 * fq, bcol0 = u.pn * BM + wc * 32 + 8 * fq;
        f32x4 bv[2][2];
#pragma unroll
        for (int bj = 0; bj < 2; ++bj)
#pragma unroll
            for (int n = 0; n < 2; ++n) bv[bj][n] = bias ? *(const f32x4*)(bias + bcol0 + bj * HALF + 4 * n) : (f32x4){0.f, 0.f, 0.f, 0.f};
#pragma unroll
        for (int ai = 0; ai < 2; ++ai)
#pragma unroll
            for (int m = 0; m < 4; ++m) { bf16_t* rowp = base + (size_t)(row0 + ai * HALF + m * 16) * ldc + col0;
#pragma unroll
                for (int bj = 0; bj < 2; ++bj) { f32x4 v0 = acc[ai][bj][m][0] + bv[bj][0], v1 = acc[ai][bj][m][1] + bv[bj][1];
                    if (ACT == 1) { f32x2 a = gelu_pk((f32x2){v0[0], v0[1]}), b = gelu_pk((f32x2){v0[2], v0[3]}), c = gelu_pk((f32x2){v1[0], v1[1]}), d = gelu_pk((f32x2){v1[2], v1[3]});
                        v0 = (f32x4){a.x, a.y, b.x, b.y}; v1 = (f32x4){c.x, c.y, d.x, d.y}; }
                    v0 = v0 * sc; v1 = v1 * sc; u32x4 w; w.x = cvt_pk_bf16(v0[0], v0[1]); w.y = cvt_pk_bf16(v0[2], v0[3]); w.z = cvt_pk_bf16(v1[0], v1[1]); w.w = cvt_pk_bf16(v1[2], v1[3]);
                    *(u32x4*)(rowp + bj * HALF) = w; } }
    }
};

struct PanelStats {
    unsigned* xbuf;
    unsigned* cnt;
    unsigned* tmo;
    int ntn; float eps;
    unsigned code;
    __device__ __forceinline__ bool run(const f32x4 (&v)[2][2][4][2], const Unit& u, int wr, int wc, int fr, int fq, PG8_LAS unsigned char* lds, int wid, int lane) const {
        typedef float f32x2v __attribute__((ext_vector_type(2)));
        PG8_LAS f32x2v* P = (PG8_LAS f32x2v*)lds;
        PG8_LAS f32x2v* S = (PG8_LAS f32x2v*)(lds + 8192);
        PG8_LAS unsigned* flag = (PG8_LAS unsigned*)(lds + 8192 + 2048);
#pragma unroll
        for (int ai = 0; ai < 2; ++ai)
#pragma unroll
            for (int m = 0; m < 4; ++m) {
                float s = 0.f;
#pragma unroll
                for (int bj = 0; bj < 2; ++bj)
#pragma unroll
                    for (int n = 0; n < 2; ++n) { const f32x4 x = v[ai][bj][m][n]; s += (x[0] + x[1]) + (x[2] + x[3]); }
                s += __shfl_xor(s, 16); s += __shfl_xor(s, 32);
                const float mw = s * (1.0f / 64.0f); float q = 0.f;
#pragma unroll
                for (int bj = 0; bj < 2; ++bj)
#pragma unroll
                    for (int n = 0; n < 2; ++n) { const f32x4 d = v[ai][bj][m][n] - mw; q += (d[0] * d[0] + d[1] * d[1]) + (d[2] * d[2] + d[3] * d[3]); }
                q += __shfl_xor(q, 16); q += __shfl_xor(q, 32);
                if (fq == 0) P[(ai * HALF + wr * 64 + m * 16 + fr) * 4 + wc] = (f32x2v){mw, q};
            }
        asm volatile("s_waitcnt lgkmcnt(0)" ::: "memory"); __builtin_amdgcn_s_barrier(); asm volatile("" ::: "memory");
#if defined(BROKEN_EXCHANGE_NO_WAIT)
#warning BROKEN CONTROL BUILD: the row-statistics exchange does not wait; results are wrong by design
        if (blockIdx.x >= 64) { const long long t0_ = clock64(); while (clock64() - t0_ < 60000) __builtin_amdgcn_s_sleep(8); }
#endif
        const int row = wid * 32 + (lane & 31);
        if (lane < 32) {
            const f32x2v a = P[row * 4 + 0], b = P[row * 4 + 1], c = P[row * 4 + 2], d = P[row * 4 + 3];
            const float mt = (a.x + b.x + c.x + d.x) * 0.25f;
            const float da = a.x - mt, db = b.x - mt, dc = c.x - mt, dd = d.x - mt;
            const float m2 = (a.y + b.y) + (c.y + d.y) + 64.0f * ((da * da + db * db) + (dc * dc + dd * dd));
            unsigned long long* slot = (unsigned long long*)xbuf + ((size_t)(u.pm * BM + row) * 4 + u.pn);
            __hip_atomic_store(slot, ((unsigned long long)__float_as_uint(m2) << 32) | __float_as_uint(mt), __ATOMIC_RELAXED, __HIP_MEMORY_SCOPE_AGENT);
        }
        asm volatile("s_waitcnt vmcnt(0)" ::: "memory");
        if (lane == 0) __hip_atomic_fetch_add(cnt + 64 * u.pm, 1u, __ATOMIC_RELAXED, __HIP_MEMORY_SCOPE_AGENT);
        if (wid == 0) {
            bool dead = false; const unsigned long long t0 = __builtin_amdgcn_s_memrealtime(); const unsigned want = 8u * (unsigned)ntn;
            for (;;) {
#if defined(BROKEN_EXCHANGE_NO_WAIT)
                break;
#endif
                if ((unsigned)__builtin_amdgcn_readfirstlane(__hip_atomic_load(cnt + 64 * u.pm, __ATOMIC_RELAXED, __HIP_MEMORY_SCOPE_AGENT)) >= want) break;
                if (__builtin_amdgcn_s_memrealtime() - t0 > 2000000ull) {
                    if (lane == 0) { unsigned expect = 0u; __hip_atomic_compare_exchange_strong(tmo + 1, &expect, code | (unsigned)(u.pm & 0xff), __ATOMIC_RELAXED, __ATOMIC_RELAXED, __HIP_MEMORY_SCOPE_AGENT);
                                     __hip_atomic_store(tmo, 1u, __ATOMIC_RELAXED, __HIP_MEMORY_SCOPE_AGENT); }
                    dead = true; break; }
                __builtin_amdgcn_s_sleep(2);
            }
            __builtin_amdgcn_fence(__ATOMIC_ACQUIRE, "agent");
            if (lane == 0) flag[0] = dead ? 1u : 0u;
        }
        asm volatile("s_waitcnt vmcnt(0) lgkmcnt(0)" ::: "memory"); __builtin_amdgcn_s_barrier(); asm volatile("" ::: "memory");
        const bool bad = flag[0] != 0u;
        if (lane < 32) {
            const unsigned long long* slot = (const unsigned long long*)xbuf + (size_t)(u.pm * BM + row) * 4; float mt[4], m2[4]; float ms = 0.f;
#pragma unroll
            for (int t = 0; t < 4; ++t) { if (t < ntn) { const unsigned long long w = __hip_atomic_load(slot + t, __ATOMIC_RELAXED, __HIP_MEMORY_SCOPE_AGENT); mt[t] = __uint_as_float((unsigned)w); m2[t] = __uint_as_float((unsigned)(w >> 32)); } else { mt[t] = 0.f; m2[t] = 0.f; } ms += mt[t]; }
            const float mean = ms / (float)ntn; float q = 0.f;
#pragma unroll
            for (int t = 0; t < 4; ++t) if (t < ntn) { const float dm = mt[t] - mean; q += m2[t] + 256.0f * dm * dm; }
            S[row] = (f32x2v){mean, 1.0f / sqrtf(q / (256.0f * (float)ntn) + eps)};
        }
        asm volatile("s_waitcnt lgkmcnt(0)" ::: "memory"); __builtin_amdgcn_s_barrier(); asm volatile("" ::: "memory");
        return bad;
    }
};
struct EpiLnRes {
    static constexpr bool PERM = false, AFTER_DRAIN = true;
    const float* base; float* out; int ldc; const float* bias; PanelStats st; unsigned poison;
    __device__ __forceinline__ void fused(f32x4 (&acc)[2][2][4][2], const Unit& u, int wr, int wc, int fr, int fq, PG8_LAS unsigned char* lds, int wid, int lane) const {
        typedef float f32x2v __attribute__((ext_vector_type(2)));
        const PG8_LAS f32x2v* S = (const PG8_LAS f32x2v*)(lds + 8192);
        const int col0 = u.pn * BM + wc * 32 + 4 * fq;
#pragma unroll
        for (int bj = 0; bj < 2; ++bj)
#pragma unroll
            for (int n = 0; n < 2; ++n) { const f32x4 bv = bias ? *(const f32x4*)(bias + col0 + bj * HALF + n * 16) : (f32x4){0.f, 0.f, 0.f, 0.f};
#pragma unroll
                for (int ai = 0; ai < 2; ++ai)
#pragma unroll
                    for (int m = 0; m < 4; ++m) acc[ai][bj][m][n] += bv; }
        f32x4 pre[4][2][2];
#pragma unroll
        for (int m = 0; m < 4; ++m) { const size_t off = (size_t)(u.pm * BM + wr * 64 + m * 16 + fr) * ldc + col0;
#pragma unroll
            for (int bj = 0; bj < 2; ++bj)
#pragma unroll
                for (int n = 0; n < 2; ++n) pre[m][bj][n] = *(const f32x4*)(base + off + bj * HALF + n * 16); }
        const bool bad = st.run(acc, u, wr, wc, fr, fq, lds, wid, lane) || poison != 0u;
        const float qnan = __builtin_nanf("");
#pragma unroll
        for (int ai = 0; ai < 2; ++ai)
#pragma unroll
            for (int m = 0; m < 4; ++m) { const int r = ai * HALF + wr * 64 + m * 16 + fr; const f32x2v sr = S[r]; const size_t off = (size_t)(u.pm * BM + r) * ldc + col0;
#pragma unroll
                for (int bj = 0; bj < 2; ++bj)
#pragma unroll
                    for (int n = 0; n < 2; ++n) { const f32x4 bs = ai == 0 ? pre[m][bj][n] : *(const f32x4*)(base + off + bj * HALF + n * 16); f32x4 o = bs + (acc[ai][bj][m][n] - sr.x) * sr.y;
                        if (bad) o = (f32x4){qnan, qnan, qnan, qnan}; *(f32x4*)(out + off + bj * HALF + n * 16) = o; }
                if (m & 1) asm volatile("" ::: "memory"); }
    }
};
struct EpiLnResLn {
    static constexpr bool PERM = false, AFTER_DRAIN = true;
    const float* base; float* out; bf16_t* xn; int ldc; const float* bias; PanelStats st1, st2; unsigned poison;
    __device__ __forceinline__ void fused(f32x4 (&acc)[2][2][4][2], const Unit& u, int wr, int wc, int fr, int fq, PG8_LAS unsigned char* lds, int wid, int lane) const {
        typedef float f32x2v __attribute__((ext_vector_type(2))); typedef unsigned u32x2v __attribute__((ext_vector_type(2)));
        const PG8_LAS f32x2v* S = (const PG8_LAS f32x2v*)(lds + 8192);
        const int col0 = u.pn * BM + wc * 32 + 4 * fq;
#pragma unroll
        for (int bj = 0; bj < 2; ++bj)
#pragma unroll
            for (int n = 0; n < 2; ++n) { const f32x4 bv = bias ? *(const f32x4*)(bias + col0 + bj * HALF + n * 16) : (f32x4){0.f, 0.f, 0.f, 0.f};
#pragma unroll
                for (int ai = 0; ai < 2; ++ai)
#pragma unroll
                    for (int m = 0; m < 4; ++m) acc[ai][bj][m][n] += bv; }
        bool bad = st1.run(acc, u, wr, wc, fr, fq, lds, wid, lane) || poison != 0u;
        const float qnan = __builtin_nanf("");
#pragma unroll
        for (int ai = 0; ai < 2; ++ai)
#pragma unroll
            for (int m = 0; m < 4; ++m) { const int r = ai * HALF + wr * 64 + m * 16 + fr; const f32x2v sr = S[r]; const size_t off = (size_t)(u.pm * BM + r) * ldc + col0;
#pragma unroll
                for (int bj = 0; bj < 2; ++bj)
#pragma unroll
                    for (int n = 0; n < 2; ++n) { const f32x4 bs = *(const f32x4*)(base + off + bj * HALF + n * 16); acc[ai][bj][m][n] = bs + (acc[ai][bj][m][n] - sr.x) * sr.y; }
                asm volatile("" : "+v"(acc[ai][0][m][0]), "+v"(acc[ai][0][m][1]), "+v"(acc[ai][1][m][0]), "+v"(acc[ai][1][m][1]));
                if (m & 1) asm volatile("" ::: "memory"); }
        const bool bad1 = bad;
        bad = st2.run(acc, u, wr, wc, fr, fq, lds, wid, lane) || bad;
#pragma unroll
        for (int ai = 0; ai < 2; ++ai)
#pragma unroll
            for (int m = 0; m < 4; ++m) { const int r = ai * HALF + wr * 64 + m * 16 + fr; const f32x2v sr = S[r]; const size_t off = (size_t)(u.pm * BM + r) * ldc + col0;
#pragma unroll
                for (int bj = 0; bj < 2; ++bj)
#pragma unroll
                    for (int n = 0; n < 2; ++n) { const f32x4 x1 = acc[ai][bj][m][n]; *(f32x4*)(out + off + bj * HALF + n * 16) = bad1 ? (f32x4){qnan, qnan, qnan, qnan} : x1;
                        const f32x4 o = (x1 - sr.x) * sr.y; u32x2v w; w.x = cvt_pk_bf16(o[0], o[1]); w.y = cvt_pk_bf16(o[2], o[3]);
                        if (bad) { w.x = 0x7fc07fc0u; w.y = 0x7fc07fc0u; } *(u32x2v*)(xn + off + bj * HALF + n * 16) = w; }
                asm volatile("" ::: "memory"); }
    }
};

struct EpiResF32 {
    static constexpr bool PERM = false, AFTER_DRAIN = false;
    float* C; int ldc; const float* baseP; const float* baseS; int split_row; float alpha;
    __device__ __forceinline__ void operator()(const f32x4 (&acc)[2][2][4][2], const Unit& u, int wr, int wc, int fr, int fq) const {
        const int row0 = u.pm * BM + wr * 64 + fr, col0 = u.pn * BM + wc * 32 + 4 * fq;
#pragma unroll
        for (int ai = 0; ai < 2; ++ai)
#pragma unroll
            for (int m = 0; m < 4; ++m) { const int row = row0 + ai * HALF + m * 16; float* rowp = C + (size_t)row * ldc + col0;
                const float* bp = (row < split_row ? baseP + (size_t)row * ldc : baseS + (size_t)(row - split_row) * ldc) + col0;
#pragma unroll
                for (int bj = 0; bj < 2; ++bj)
#pragma unroll
                    for (int n = 0; n < 2; ++n) { const f32x4 b = *(const f32x4*)(bp + bj * HALF + n * 16); *(f32x4*)(rowp + bj * HALF + n * 16) = acc[ai][bj][m][n] + b * alpha; } }
    }
};
struct EpiSwiGLU {
    static constexpr bool PERM = true, AFTER_DRAIN = false;
    bf16_t* O; int ldc;
    __device__ __forceinline__ void operator()(const f32x4 (&acc)[2][2][4][2], const Unit& u, int wr, int wc, int fr, int fq) const {
        const int row0 = u.pm * BM + wr * 64 + fr, col0 = u.pn * HALF + wc * 32 + 8 * fq;
#pragma unroll
        for (int ai = 0; ai < 2; ++ai)
#pragma unroll
            for (int m = 0; m < 4; ++m) { bf16_t* rowp = O + (size_t)(row0 + ai * HALF + m * 16) * ldc + col0;
                float h[8];
#pragma unroll
                for (int n = 0; n < 2; ++n)
#pragma unroll
                    for (int e = 0; e < 4; ++e) { const float g = acc[ai][0][m][n][e], up = acc[ai][1][m][n][e]; h[n * 4 + e] = g * __builtin_amdgcn_rcpf(1.0f + __expf(-g)) * up; }
                u32x4 w; w.x = cvt_pk_bf16(h[0], h[1]); w.y = cvt_pk_bf16(h[2], h[3]); w.z = cvt_pk_bf16(h[4], h[5]); w.w = cvt_pk_bf16(h[6], h[7]);
                *(u32x4*)rowp = w; }
    }
};
template <class Epi, class Sched, bool ALIGN_EPI = false, bool SP2 = false>
__device__ __forceinline__ void gemm_phase(PG8_LAS unsigned char* lds, const Gemm g, const Sched& S, const Epi& E) {
    int tid_l = threadIdx.x; asm volatile("" : "+v"(tid_l));
    const int tid = tid_l, wid = __builtin_amdgcn_readfirstlane(tid >> 6), lane = tid & 63, wr = wid >> 2, wc = wid & 3, fr = lane & 15, fq = lane >> 4;
    const int K = g.K, nt = K / BK;
    unsigned voffA[2], voffB[2];
#pragma unroll
    for (int i = 0; i < 2; ++i) { int R, C; stage_rc(tid * 16 + i * 8192, R, C); const int Rb = Epi::PERM ? ((R & ~31) + perm32(R & 31)) : R;
        voffA[i] = (unsigned)(R * K + C) * 2u; voffB[i] = (unsigned)(Rb * K + C) * 2u; }
    const size_t kstep = (size_t)(BK * 2);
    const size_t hstep = (size_t)HALF * K * 2;
    const size_t tstep = 2 * hstep;
    const unsigned ldsw = (unsigned)wid * 1024u;
    const int aoff = lds_byte(wr * 64 + fr, fq * 8), boff = lds_byte(wc * 32 + fr, fq * 8);
#define PG8_SA(b, h) (((b) * 2 + (h)) * HTB)
#define PG8_SB(b, h) ((4 + (b) * 2 + (h)) * HTB)
#define PG8_STAGE(bufoff, gbase, voff) do { _Pragma("unroll") for (int _i = 0; _i < 2; ++_i) \
        __builtin_amdgcn_global_load_lds((const unsigned*)((const char*)(gbase) + (voff)[_i]), (PG8_LAS unsigned*)(lds + (bufoff) + ldsw + _i * 8192), 16, 0, 0); } while (0)
#define PG8_LDA(dst, b, h) do { _Pragma("unroll") for (int m = 0; m < 4; ++m) _Pragma("unroll") for (int k = 0; k < 2; ++k) dst[m][k] = *(const PG8_LAS bf16x8*)(lds + PG8_SA(b, h) + aoff + m * 2048 + k * 1024); } while (0)
#define PG8_LDB(dst, b, h) do { _Pragma("unroll") for (int n = 0; n < 2; ++n) _Pragma("unroll") for (int k = 0; k < 2; ++k) dst[n][k] = *(const PG8_LAS bf16x8*)(lds + PG8_SB(b, h) + boff + n * 2048 + k * 1024); } while (0)
#define PG8_MMA(ai, bj, At, Bt) do { __builtin_amdgcn_s_setprio(1); _Pragma("unroll") for (int m = 0; m < 4; ++m) _Pragma("unroll") for (int n = 0; n < 2; ++n) _Pragma("unroll") for (int k = 0; k < 2; ++k) \
        acc[ai][bj][m][n] = __builtin_amdgcn_mfma_f32_16x16x32_bf16(Bt[n][k], At[m][k], acc[ai][bj][m][n], 0, 0, 0); __builtin_amdgcn_s_setprio(0); } while (0)
#define PG8_WAIT_V(n) asm volatile("s_waitcnt vmcnt(" #n ")" ::: "memory")
#define PG8_WAIT_L(n) asm volatile("s_waitcnt lgkmcnt(" #n ")" ::: "memory")
#define PG8_BAR __builtin_amdgcn_s_barrier()
#define PG8_SCHED __builtin_amdgcn_sched_barrier(0)
    Unit cur, nxt; int ui = 0;
    if (!S.next(0, cur)) return;
    f32x4 acc[2][2][4][2];
#pragma unroll
    for (int a = 0; a < 2; ++a)
#pragma unroll
        for (int b = 0; b < 2; ++b)
#pragma unroll
            for (int m = 0; m < 4; ++m)
#pragma unroll
                for (int n = 0; n < 2; ++n) acc[a][b][m][n] = (f32x4){0.f, 0.f, 0.f, 0.f};
    bf16x8 At[4][2], B0[2][2], B1[2][2];
    const char* cA = (const char*)g.A + (size_t)cur.pm * tstep; const char* cB = (const char*)g.Bt + (size_t)cur.pn * tstep;
    S.a_ready(cur);
    if constexpr (SP2) {
        PG8_STAGE(PG8_SB(0, 0), cB, voffB); PG8_STAGE(PG8_SB(0, 1), cB + hstep, voffB); PG8_STAGE(PG8_SA(0, 0), cA, voffA); PG8_STAGE(PG8_SA(0, 1), cA + hstep, voffA);
        if (wr == 1) PG8_BAR;
        PG8_WAIT_V(2); PG8_BAR;
        PG8_STAGE(PG8_SB(1, 0), cB + kstep, voffB); PG8_STAGE(PG8_SA(1, 0), cA + kstep, voffA); PG8_STAGE(PG8_SB(1, 1), cB + hstep + kstep, voffB);
        PG8_WAIT_V(6); PG8_BAR;
    } else {
        PG8_STAGE(PG8_SB(0, 0), cB, voffB); PG8_STAGE(PG8_SA(0, 0), cA, voffA); PG8_STAGE(PG8_SB(0, 1), cB + hstep, voffB); PG8_STAGE(PG8_SA(0, 1), cA + hstep, voffA);
        if (wr == 1) PG8_BAR;
        PG8_WAIT_V(4); PG8_BAR;
        PG8_STAGE(PG8_SB(1, 0), cB + kstep, voffB); PG8_STAGE(PG8_SA(1, 0), cA + kstep, voffA); PG8_STAGE(PG8_SB(1, 1), cB + hstep + kstep, voffB);
        PG8_WAIT_V(6); PG8_BAR;
    }
    for (;;) {
        const bool has_next = S.next(ui + 1, nxt);
        const char* nA = has_next ? (const char*)g.A + (size_t)nxt.pm * tstep : cA; const char* nB = has_next ? (const char*)g.Bt + (size_t)nxt.pn * tstep : cB;
        for (int t = 0; t < nt; t += 2) {
            const bool last = (t == nt - 2);
            const char* a1 = cA + (size_t)(t + 1) * kstep;
            const char* a2 = last ? nA : cA + (size_t)(t + 2) * kstep; const char* b2 = last ? nB : cB + (size_t)(t + 2) * kstep;
            const char* a3 = a2 + kstep; const char* b3 = b2 + kstep;
            if (last && has_next) S.a_ready(nxt);
            if constexpr (SP2) {
            PG8_LDB(B0, 0, 0); PG8_LDB(B1, 0, 1); PG8_SCHED; PG8_LDA(At, 0, 0); PG8_STAGE(PG8_SA(1, 1), a1 + hstep, voffA);
            PG8_WAIT_V(8); PG8_WAIT_L(0); PG8_BAR; PG8_MMA(0, 0, At, B0); PG8_MMA(0, 1, At, B1); PG8_BAR; PG8_SCHED;
            PG8_LDA(At, 0, 1); PG8_STAGE(PG8_SB(0, 0), b2, voffB); PG8_STAGE(PG8_SB(0, 1), b2 + hstep, voffB); PG8_STAGE(PG8_SA(0, 0), a2, voffA);
            PG8_WAIT_V(8); PG8_WAIT_L(0); PG8_BAR; PG8_MMA(1, 0, At, B0); PG8_MMA(1, 1, At, B1); PG8_BAR; PG8_SCHED;
            PG8_LDB(B0, 1, 0); PG8_LDB(B1, 1, 1); PG8_SCHED; PG8_LDA(At, 1, 0); PG8_STAGE(PG8_SA(0, 1), a2 + hstep, voffA);
            PG8_WAIT_V(8); PG8_WAIT_L(0); PG8_BAR; PG8_MMA(0, 0, At, B0); PG8_MMA(0, 1, At, B1); PG8_BAR; PG8_SCHED;
            PG8_LDA(At, 1, 1); PG8_STAGE(PG8_SB(1, 0), b3, voffB); PG8_STAGE(PG8_SB(1, 1), b3 + hstep, voffB); PG8_STAGE(PG8_SA(1, 0), a3, voffA);
            PG8_WAIT_V(8); PG8_WAIT_L(0); PG8_BAR; PG8_MMA(1, 0, At, B0); PG8_MMA(1, 1, At, B1); PG8_BAR; PG8_SCHED;
            } else {
            PG8_LDB(B0, 0, 0); PG8_SCHED; PG8_LDA(At, 0, 0); PG8_STAGE(PG8_SA(1, 1), a1 + hstep, voffA);
            PG8_WAIT_L(8); PG8_BAR; PG8_WAIT_L(0); PG8_MMA(0, 0, At, B0); PG8_BAR; PG8_SCHED;
            PG8_LDB(B1, 0, 1); PG8_STAGE(PG8_SB(0, 0), b2, voffB);
            PG8_BAR; PG8_WAIT_L(0); PG8_MMA(0, 1, At, B1); PG8_BAR;
            PG8_LDA(At, 0, 1); PG8_STAGE(PG8_SA(0, 0), a2, voffA);
            PG8_BAR; PG8_WAIT_L(0); PG8_MMA(1, 0, At, B0); PG8_BAR; PG8_SCHED;
            PG8_STAGE(PG8_SB(0, 1), b2 + hstep, voffB);
            PG8_WAIT_V(6); PG8_BAR; PG8_MMA(1, 1, At, B1); PG8_BAR;
            PG8_LDB(B0, 1, 0); PG8_SCHED; PG8_LDA(At, 1, 0); PG8_STAGE(PG8_SA(0, 1), a2 + hstep, voffA);
            PG8_WAIT_L(8); PG8_BAR; PG8_WAIT_L(0); PG8_MMA(0, 0, At, B0); PG8_BAR; PG8_SCHED;
            PG8_LDB(B1, 1, 1); PG8_STAGE(PG8_SB(1, 0), b3, voffB);
            PG8_BAR; PG8_WAIT_L(0); PG8_MMA(0, 1, At, B1); PG8_BAR;
            PG8_LDA(At, 1, 1); PG8_STAGE(PG8_SA(1, 0), a3, voffA);
            PG8_BAR; PG8_WAIT_L(0); PG8_MMA(1, 0, At, B0); PG8_BAR; PG8_SCHED;
            PG8_STAGE(PG8_SB(1, 1), b3 + hstep, voffB);
            PG8_WAIT_V(6); PG8_BAR; PG8_MMA(1, 1, At, B1); PG8_BAR;
            }
        }
        if constexpr (ALIGN_EPI) { if (wr == 0) PG8_BAR; }
        if constexpr (!Epi::AFTER_DRAIN) { E(acc, cur, wr, wc, fr, fq); S.done(cur); }
        if (!has_next) break;
#pragma unroll
        for (int a = 0; a < 2; ++a)
#pragma unroll
            for (int b = 0; b < 2; ++b)
#pragma unroll
                for (int m = 0; m < 4; ++m)
#pragma unroll
                    for (int n = 0; n < 2; ++n) acc[a][b][m][n] = (f32x4){0.f, 0.f, 0.f, 0.f};
        cur = nxt; cA = nA; cB = nB; ++ui;
        if constexpr (ALIGN_EPI) { if (wr == 1) PG8_BAR; }
    }
    PG8_WAIT_V(0);
    if constexpr (!ALIGN_EPI) { if (wr == 0) PG8_BAR; }
    PG8_BAR;
    if constexpr (Epi::AFTER_DRAIN) { E.fused(acc, cur, wr, wc, fr, fq, lds, wid, lane); S.done(cur); }
#undef PG8_SA
#undef PG8_SB
#undef PG8_STAGE
#undef PG8_LDA
#undef PG8_LDB
#undef PG8_MMA
#undef PG8_WAIT_V
#undef PG8_WAIT_L
#undef PG8_BAR
#undef PG8_SCHED
}
}

#ifndef MK_ONE_LAUNCH
#define MK_ONE_LAUNCH 1
#endif
namespace cg = cooperative_groups;
constexpr int NWAVES = 8, NTHREADS = 512;
constexpr int DM = 1024, BATCH = 8, SEQ = 2048, DECB = 128, DECS = 4, DEPTH = 4;
constexpr int TP = BATCH * SEQ, TS = DECB * DECS, TT = TP + TS;
constexpr int HA = 4, DKA = 128, DVA = 128, CONVD = 1536, HQB = 8, HKVB = 2, HDB = 64, WIN = 128;
constexpr int NPROJ = 2816, NPROJ_SRC = 2824, DFF = 2816, NFI = 5632;
constexpr int C_QA = 0, C_KA = 512, C_VA = 1024, C_ZA = 1536, C_QB = 2048, C_KB = 2560, C_VB = 2688;
constexpr float ALPHA = 1.681792830507429f, EPS = 1e-6f;
constexpr size_t O_YP = 0, O_YS = 16777216, O_DP = 17301504, O_CP = 19398656, O_KP = 19546112, O_VP = 20070400, O_DS = 20594688, O_CS = 54149120, O_KS = 56508416, O_VS = 64897024, O_END = 73285632;
constexpr size_t MiB = 1u << 20;
constexpr size_t WS_CTL = 0, CTL_ZERO_BYTES = 1 * MiB;
constexpr size_t WS_XCH = 1 * MiB;
constexpr size_t WS_W = 4 * MiB, WL_IN = 0, WL_OUT = 5767168, WL_FI = 7864320, WL_FO = 19398656, WL_STRIDE = 25165824;
constexpr size_t WS_WBA = 100 * MiB;
constexpr size_t WS_XB = 104 * MiB;
constexpr size_t WS_PROJ = 138 * MiB;
constexpr size_t WS_H = WS_PROJ;
constexpr size_t WS_MIXED = 230 * MiB;
constexpr size_t WS_QKV = 264 * MiB;
constexpr size_t WS_BG = 364 * MiB;
constexpr size_t WS_OA = 366 * MiB;
constexpr size_t WS_Y = 400 * MiB;
constexpr size_t WS_END = 468 * MiB;
constexpr int CW_BAR = 4096;
constexpr int RING_BYTES = 131072, LDSCTL_OFF = RING_BYTES, MISC_OFF = LDSCTL_OFF + 320, LDS_BYTES = 147456;

#define GAS __attribute__((address_space(1)))
#define LAS __attribute__((address_space(3)))
typedef unsigned short bf16;
typedef unsigned v4u __attribute__((ext_vector_type(4)));
typedef unsigned v2u __attribute__((ext_vector_type(2)));
typedef float f32x4 __attribute__((ext_vector_type(4)));
typedef GAS unsigned gu32;
#define RLX_AGENT __ATOMIC_RELAXED, __HIP_MEMORY_SCOPE_AGENT
#define LDS_WAIT() asm volatile("s_waitcnt lgkmcnt(0)" ::: "memory")
#define VM_WAIT() asm volatile("s_waitcnt vmcnt(0)" ::: "memory")
__device__ __forceinline__ unsigned f2bf(float f) { unsigned u = __builtin_bit_cast(unsigned, f); return (u + 0x7fffu + ((u >> 16) & 1u)) >> 16; }
__device__ __forceinline__ unsigned pk2(float lo, float hi) { return f2bf(lo) | (f2bf(hi) << 16); }
__device__ __forceinline__ float bf2f(unsigned short h) { return __builtin_bit_cast(float, (unsigned)h << 16); }
__device__ __forceinline__ float bflo(unsigned w) { return __builtin_bit_cast(float, w << 16); }
__device__ __forceinline__ float bfhi(unsigned w) { return __builtin_bit_cast(float, w & 0xffff0000u); }
__device__ __forceinline__ void unpack8(const v4u w, float* f) { f[0] = bflo(w.x); f[1] = bfhi(w.x); f[2] = bflo(w.y); f[3] = bfhi(w.y); f[4] = bflo(w.z); f[5] = bfhi(w.z); f[6] = bflo(w.w); f[7] = bfhi(w.w); }
__device__ __forceinline__ float siluf(float x) { return x / (1.0f + __expf(-x)); }
__device__ __forceinline__ float wave_sum(float v) {
#pragma unroll
    for (int o = 1; o < 64; o <<= 1) v += __shfl_xor(v, o);
    return v;
}
__device__ __forceinline__ float wave_max(float v) {
#pragma unroll
    for (int o = 1; o < 64; o <<= 1) v = fmaxf(v, __shfl_xor(v, o));
    return v;
}
#define XB_TMO      128
#define XB_XCNT(j)  (256  + 64 * (j))
#define XB_XSUB(j)  (1280 + 64 * (j))
#define XB_XGEN(j)  (2304 + 64 * (j))
#define XB_TOP      3328
#define XB_TOPGEN   3392
#define XCD_BAR_WORDS 3456
#define XB_SPIN_CAP (1u << 18)

__device__ __forceinline__ unsigned xb_ld(unsigned* p)              { return __hip_atomic_load(p, __ATOMIC_RELAXED, __HIP_MEMORY_SCOPE_AGENT); }
__device__ __forceinline__ unsigned xb_add(unsigned* p, unsigned v) { return __hip_atomic_fetch_add(p, v, __ATOMIC_RELAXED, __HIP_MEMORY_SCOPE_AGENT); }
__device__ __forceinline__ unsigned xb_xcc_id() { return (unsigned)__builtin_amdgcn_s_getreg((3 << 11) | 20) & 0xFu; }
#define XB_SPIN(cond, bar) do { unsigned _sp = 0; while (cond) { __builtin_amdgcn_s_sleep(1); \
    if ((++_sp & 255u) == 0u) { if (xb_ld(&(bar)[XB_TMO])) break; if (_sp > XB_SPIN_CAP) { atomicAdd(&(bar)[XB_TMO], 1u); break; } } } } while (0)

struct XcdBarrier {
    unsigned* bar; unsigned x;
    volatile LAS unsigned* st;
};

__device__ __forceinline__ XcdBarrier xcd_barrier_post(unsigned* bar, volatile LAS unsigned* st) {
    XcdBarrier b; b.bar = bar; b.x = xb_xcc_id(); b.st = st;
    if (threadIdx.x == 0) (void)xb_add(&bar[XB_XCNT(b.x)], 1u);
    return b;
}
__device__ __forceinline__ void xcd_barrier_complete(unsigned* bar, unsigned x, unsigned& nloc, unsigned& nx) {
    const unsigned G = gridDim.x * gridDim.y * gridDim.z;
    unsigned sum, cnt, mine, sp = 0u;
    for (;;) {
        sum = 0u; cnt = 0u; mine = 0u;
#pragma unroll
        for (unsigned j = 0; j < 16; ++j) { const unsigned c = xb_ld(&bar[XB_XCNT(j)]); sum += c; cnt += (c > 0u) ? 1u : 0u; mine = (j == x) ? c : mine; }
        if (sum == G) break;
        __builtin_amdgcn_s_sleep(1);
        if ((++sp & 255u) == 0u) { if (xb_ld(&bar[XB_TMO])) break; if (sp > XB_SPIN_CAP) { atomicAdd(&bar[XB_TMO], 1u); break; } }
    }
    nloc = mine > 0u ? mine : 1u; nx = cnt > 0u ? cnt : 1u;
}

__device__ __forceinline__ void xcd_barrier(const XcdBarrier& b) {
    asm volatile("s_waitcnt vmcnt(0)" ::: "memory");
    __syncthreads();
    if (threadIdx.x == 0) {
        unsigned* bar = b.bar;
        __builtin_amdgcn_s_waitcnt(0);
        unsigned nloc = b.st[0], nx = b.st[1];
        if (nloc == 0u) { xcd_barrier_complete(bar, b.x, nloc, nx); b.st[0] = nloc; b.st[1] = nx; }
        const unsigned old = xb_add(&bar[XB_XSUB(b.x)], 1u);
        const unsigned gen = old / nloc;
        if (old + 1u == (gen + 1u) * nloc) {
            __builtin_amdgcn_fence(__ATOMIC_RELEASE, "agent");
            asm volatile("s_waitcnt vmcnt(0)" ::: "memory");
            const unsigned og = xb_add(&bar[XB_TOP], 1u);
            const unsigned tg = og / nx;
            if (og + 1u == (tg + 1u) * nx) xb_add(&bar[XB_TOPGEN], 1u);
            else XB_SPIN(xb_ld(&bar[XB_TOPGEN]) == tg, bar);
            __builtin_amdgcn_fence(__ATOMIC_ACQUIRE, "agent");
            xb_add(&bar[XB_XGEN(b.x)], 1u);
            asm volatile("s_waitcnt vmcnt(0)" ::: "memory");
        } else {
            XB_SPIN(xb_ld(&bar[XB_XGEN(b.x)]) == gen, bar);
            __builtin_amdgcn_fence(__ATOMIC_ACQUIRE, "agent");
            asm volatile("s_waitcnt vmcnt(0)" ::: "memory");
        }
    }
    __syncthreads();
}
struct Args { const float* in[19]; float* out; unsigned char* ws; int ph_lo, ph_hi; };
typedef const __attribute__((address_space(4))) Args* KA;

__device__ __forceinline__ void transpose_item(const float* W, int ldn, int src_col0, int k0, int K, bf16* WT, int dst_row0, LAS float* scr, int lane) {
#pragma unroll 8
    for (int i = 0; i < 32; ++i) { const int kk = 2 * i + (lane >> 5); scr[kk * 33 + (lane & 31)] = W[(size_t)(k0 + kk) * ldn + src_col0 + (lane & 31)]; }
    LDS_WAIT(); asm volatile("" ::: "memory");
    const int c = lane & 7;
#pragma unroll
    for (int j = 0; j < 4; ++j) { const int n = (lane >> 3) + 8 * j; const LAS float* s = scr + (8 * c) * 33 + n;
        v4u o; o.x = pk2(s[0 * 33], s[1 * 33]); o.y = pk2(s[2 * 33], s[3 * 33]); o.z = pk2(s[4 * 33], s[5 * 33]); o.w = pk2(s[6 * 33], s[7 * 33]);
        *(GAS v4u*)(WT + (size_t)(dst_row0 + n) * K + k0 + 8 * c) = o; }
    LDS_WAIT(); asm volatile("" ::: "memory");
}
__device__ __forceinline__ void ph_prologue(KA A, LAS unsigned char* lds, int bid, int G, int tid) {
    asm volatile("" : "+v"(tid));
    const int wave = __builtin_amdgcn_readfirstlane(tid >> 6), lane = tid & 63;
    LAS float* scr = (LAS float*)(lds + wave * 16384);
    const int gw = bid * NWAVES + wave, NGW = G * NWAVES;
    constexpr int I_IN = 16 * 88, I_OUT = 16 * 32, I_FI = 16 * 176, I_FO = 44 * 32, I_L = I_IN + I_OUT + I_FI + I_FO;
    for (int it = gw; it < DEPTH * I_L; it += NGW) {
        const int l = it / I_L; int r = it % I_L;
        bf16* wl = (bf16*)(A->ws + WS_W + (size_t)l * WL_STRIDE);
        if (r < I_IN) { const int kb = r / 88, nb = r % 88, d0 = 32 * nb, s0 = d0 < 2048 ? d0 : d0 + 8;
            transpose_item(A->in[6] + (size_t)l * DM * NPROJ_SRC, NPROJ_SRC, s0, 64 * kb, DM, wl + WL_IN / 2, d0, scr, lane); continue; }
        r -= I_IN;
        if (r < I_OUT) { const int kb = r / 32, nb = r % 32;
            transpose_item(A->in[12] + (size_t)l * DM * DM, DM, 32 * nb, 64 * kb, DM, wl + WL_OUT / 2, 32 * nb, scr, lane); continue; }
        r -= I_OUT;
        if (r < I_FI) { const int kb = r / 176, nb = r % 176, d0 = 32 * nb, s0 = ((d0 >> 7) & 1) * DFF + (d0 >> 8) * 128 + (d0 & 127);
            transpose_item(A->in[15] + (size_t)l * DM * NFI, NFI, s0, 64 * kb, DM, wl + WL_FI / 2, d0, scr, lane); continue; }
        r -= I_FI;
        { const int kb = r / 32, nb = r % 32;
            transpose_item(A->in[16] + (size_t)l * DFF * DM, DM, 32 * nb, 64 * kb, DFF, wl + WL_FO / 2, 32 * nb, scr, lane); }
    }
    { float* wba = (float*)(A->ws + WS_WBA);
      for (int i = bid * NTHREADS + tid; i < DEPTH * 8 * DM; i += G * NTHREADS) { const int l = i >> 13, c = (i >> 10) & 7, k = i & 1023;
          wba[i] = A->in[6][((size_t)l * DM + k) * NPROJ_SRC + 2048 + c]; } }
    { bf16* XB = (bf16*)(A->ws + WS_XB);
      for (int m = gw; m < TT; m += NGW) {
          const float* src = m < TP ? A->in[0] + (size_t)m * DM : A->in[1] + (size_t)(m - TP) * DM;
          const f32x4* xr = (const f32x4*)src + lane; v2u* o8 = (v2u*)(XB + (size_t)m * DM) + lane;
#pragma unroll
          for (int j = 0; j < 4; ++j) { const f32x4 v = xr[64 * j]; v2u w; w.x = pk2(v.x, v.y); w.y = pk2(v.z, v.w); o8[64 * j] = w; } } }
}

__device__ __forceinline__ void ph_baconv(KA A, int l, LAS unsigned char* lds, int bid, int G, int tid) {
    asm volatile("" : "+v"(tid));
    const int wave = __builtin_amdgcn_readfirstlane(tid >> 6), lane = tid & 63;
    LAS float* wl = (LAS float*)lds;
    { const f32x4* wba = (const f32x4*)((const float*)(A->ws + WS_WBA) + (size_t)l * 8192);
      for (int i = tid; i < 2048; i += NTHREADS) ((LAS f32x4*)wl)[i] = wba[i]; }
    __syncthreads();
    const bf16* XB = (const bf16*)(A->ws + WS_XB); const bf16* PROJ = (const bf16*)(A->ws + WS_PROJ);
    float* QKV = (float*)(A->ws + WS_QKV); float* BG = (float*)(A->ws + WS_BG);
    const float* convw = A->in[7] + (size_t)l * 4 * CONVD;
    const int h = lane >> 4, d8 = (lane & 15) * 8;
    for (int row = bid * NWAVES + wave; row < TT; row += G * NWAVES) {
        { const v4u x0 = *(const v4u*)(XB + (size_t)row * DM + lane * 8), x1 = *(const v4u*)(XB + (size_t)row * DM + 512 + lane * 8);
          float xf[16]; unpack8(x0, xf); unpack8(x1, xf + 8);
          float mine = 0.f;
#pragma unroll
          for (int c = 0; c < 8; ++c) { float acc = 0.f;
#pragma unroll
              for (int j = 0; j < 8; ++j) acc += xf[j] * wl[c * 1024 + lane * 8 + j];
#pragma unroll
              for (int j = 0; j < 8; ++j) acc += xf[8 + j] * wl[c * 1024 + 512 + lane * 8 + j];
              acc = wave_sum(acc); if (lane == c) mine = acc; }
          if (lane < 8) { float o;
              if (lane < 4) o = 1.0f / (1.0f + __expf(-mine));
              else { const int hh = lane - 4; float sp = mine + A->in[9][l * 4 + hh]; sp = sp > 20.f ? sp : log1pf(__expf(sp)); o = -__expf(A->in[8][l * 4 + hh]) * sp; }
              BG[(size_t)row * 8 + lane] = o; } }
        const bool isP = row < TP; const int pos = isP ? (row % SEQ) : ((row - TP) % DECS); const int bs = isP ? (row / SEQ) : ((row - TP) / DECS);
#pragma unroll
        for (int sec = 0; sec < 3; ++sec) { const int c0 = sec * 512 + h * 128 + d8;
            float y[8], xlast[8];
#pragma unroll
            for (int j = 0; j < 8; ++j) { y[j] = 0.f; xlast[j] = 0.f; }
#pragma unroll
            for (int jj = 0; jj < 4; ++jj) { const int tp = pos - 3 + jj; float xv[8];
                if (tp >= 0) { const v4u w = *(const v4u*)(PROJ + (size_t)(row - 3 + jj) * NPROJ + c0); unpack8(w, xv); }
                else if (isP) {
#pragma unroll
                    for (int j = 0; j < 8; ++j) xv[j] = 0.f; }
                else { const float* sc = A->in[3] + (((size_t)l * DECB + bs) * 3 + (tp + 3)) * CONVD + c0; const f32x4 a0 = *(const f32x4*)sc, a1 = *(const f32x4*)(sc + 4);
                    xv[0] = a0.x; xv[1] = a0.y; xv[2] = a0.z; xv[3] = a0.w; xv[4] = a1.x; xv[5] = a1.y; xv[6] = a1.z; xv[7] = a1.w; }
                const f32x4 w0 = *(const f32x4*)(convw + jj * CONVD + c0), w1 = *(const f32x4*)(convw + jj * CONVD + c0 + 4);
                y[0] += w0.x * xv[0]; y[1] += w0.y * xv[1]; y[2] += w0.z * xv[2]; y[3] += w0.w * xv[3]; y[4] += w1.x * xv[4]; y[5] += w1.y * xv[5]; y[6] += w1.z * xv[6]; y[7] += w1.w * xv[7];
                if (jj == 3) {
#pragma unroll
                    for (int j = 0; j < 8; ++j) xlast[j] = xv[j]; } }
#pragma unroll
            for (int j = 0; j < 8; ++j) y[j] = siluf(y[j]);
            if (sec < 2) { float ss = 0.f;
#pragma unroll
                for (int j = 0; j < 8; ++j) ss += y[j] * y[j];
                ss += __shfl_xor(ss, 1); ss += __shfl_xor(ss, 2); ss += __shfl_xor(ss, 4); ss += __shfl_xor(ss, 8);
                const float rs = (1.0f / sqrtf(ss + EPS)) * (sec == 0 ? 0.08838834764831845f : 1.0f);
#pragma unroll
                for (int j = 0; j < 8; ++j) y[j] *= rs; }
            float* qd = QKV + (size_t)row * CONVD + c0;
            *(f32x4*)qd = (f32x4){y[0], y[1], y[2], y[3]}; *(f32x4*)(qd + 4) = (f32x4){y[4], y[5], y[6], y[7]};
            float* cd = nullptr;
            if (isP) { if (pos >= SEQ - 3) cd = A->out + O_CP + (((size_t)l * BATCH + bs) * 3 + (pos - (SEQ - 3))) * CONVD + c0; }
            else { if (pos >= 1) cd = A->out + O_CS + (((size_t)l * DECB + bs) * 3 + (pos - 1)) * CONVD + c0; }
            if (cd) { *(f32x4*)cd = (f32x4){xlast[0], xlast[1], xlast[2], xlast[3]}; *(f32x4*)(cd + 4) = (f32x4){xlast[4], xlast[5], xlast[6], xlast[7]}; }
        }
    }
    __syncthreads();
}

__device__ __forceinline__ void delta_naive_unit(KA A, int l, int u, LAS unsigned char* lds, int tid) {
    asm volatile("" : "+v"(tid));
    LAS float* stage = (LAS float*)lds;
    LAS float* part0 = stage + 2 * 392;
    LAS float* part1 = part0 + 512;
    const int dv = tid & 127, grp = tid >> 7, dk0 = grp * 32;
    const bool isP = u < 32; const int uu = isP ? u : u - 32; const int b = uu >> 2, h = uu & 3; const int L = isP ? SEQ : DECS;
    const size_t row0 = isP ? (size_t)b * SEQ : (size_t)TP + (size_t)b * DECS;
    const float* QKV = (const float*)(A->ws + WS_QKV); const float* BG = (const float*)(A->ws + WS_BG); float* OA = (float*)(A->ws + WS_OA);
    float S[32];
    if (isP) {
#pragma unroll
        for (int i = 0; i < 32; ++i) S[i] = 0.f; }
    else { const float* s0 = A->in[2] + ((((size_t)l * DECB + b) * HA + h) * DKA) * DVA;
#pragma unroll
        for (int i = 0; i < 32; ++i) S[i] = s0[(size_t)(dk0 + i) * DVA + dv]; }
#define DN_PREFETCH(t_, buf_) do { const size_t r_ = row0 + (t_); LAS float* s_ = stage + (buf_) * 392; \
        if (tid < 384) s_[tid] = QKV[r_ * CONVD + (tid >> 7) * 512 + h * 128 + (tid & 127)]; \
        else if (tid == 384) s_[384] = __expf(BG[r_ * 8 + 4 + h]); else if (tid == 385) s_[385] = BG[r_ * 8 + h]; } while (0)
    DN_PREFETCH(0, 0);
    __syncthreads();
    for (int t = 0; t < L; ++t) {
        const int cur = t & 1; const LAS float* st = stage + cur * 392;
        if (t + 1 < L) DN_PREFETCH(t + 1, cur ^ 1);
        const float a = st[384], be = st[385], v = st[256 + dv];
        float kk[32], qq[32];
#pragma unroll
        for (int i = 0; i < 32; ++i) { kk[i] = st[128 + dk0 + i]; qq[i] = st[dk0 + i]; }
        float pk = 0.f;
#pragma unroll
        for (int i = 0; i < 32; ++i) pk += kk[i] * S[i];
        part0[grp * 128 + dv] = pk;
        __syncthreads();
        const float kS = (part0[dv] + part0[128 + dv]) + (part0[256 + dv] + part0[384 + dv]);
        const float dl = be * (v - a * kS);
        float po = 0.f;
#pragma unroll
        for (int i = 0; i < 32; ++i) { S[i] = a * S[i] + kk[i] * dl; po += qq[i] * S[i]; }
        part1[grp * 128 + dv] = po;
        __syncthreads();
        if (grp == 0) OA[(row0 + t) * 512 + h * 128 + dv] = (part1[dv] + part1[128 + dv]) + (part1[256 + dv] + part1[384 + dv]);
    }
#undef DN_PREFETCH
    __syncthreads();
    float* dst = (isP ? A->out + O_DP + (((size_t)l * BATCH + b) * HA + h) * DKA * DVA : A->out + O_DS + (((size_t)l * DECB + b) * HA + h) * DKA * DVA);
#pragma unroll
    for (int i = 0; i < 32; ++i) dst[(size_t)(dk0 + i) * DVA + dv] = S[i];
}

__device__ __forceinline__ void swa_naive_unit(KA A, int l, int row, int hq, int lane) {
    const int kvh = hq >> 2;
    const bf16* PROJ = (const bf16*)(A->ws + WS_PROJ); bf16* MIXED = (bf16*)(A->ws + WS_MIXED);
    float q[64];
    { const v4u* qp = (const v4u*)(PROJ + (size_t)row * NPROJ + C_QB + hq * 64);
#pragma unroll
      for (int i = 0; i < 8; ++i) unpack8(qp[i], q + 8 * i); }
    const bool isP = row < TP; const int pos = isP ? (row % SEQ) : ((row - TP) % DECS); const int bs = isP ? (row / SEQ) : ((row - TP) / DECS);
    const float* ck = A->in[4] + ((size_t)l * DECB + bs) * WIN * HKVB * HDB; const float* cv = A->in[5] + ((size_t)l * DECB + bs) * WIN * HKVB * HDB;
    float sc[2];
#pragma unroll
    for (int ks = 0; ks < 2; ++ks) { const int jj = lane + 64 * ks; float s = -INFINITY;
        const bf16* kp = nullptr; const float* kf = nullptr;
        if (isP) { if (pos - 127 + jj >= 0) kp = PROJ + (size_t)(row - 127 + jj) * NPROJ + C_KB + kvh * 64; }
        else { const int e = pos + 1 + jj; if (e < WIN) kf = ck + ((size_t)e * HKVB + kvh) * HDB; else kp = PROJ + (size_t)(TP + bs * DECS + (e - WIN)) * NPROJ + C_KB + kvh * 64; }
        if (kp) { float d = 0.f;
#pragma unroll
            for (int i = 0; i < 8; ++i) { float kx[8]; unpack8(((const v4u*)kp)[i], kx);
#pragma unroll
                for (int j = 0; j < 8; ++j) d += q[8 * i + j] * kx[j]; }
            s = d * 0.125f; }
        else if (kf) { float d = 0.f;
#pragma unroll
            for (int i = 0; i < 16; ++i) { const f32x4 kx = ((const f32x4*)kf)[i]; d += q[4 * i] * kx.x + q[4 * i + 1] * kx.y + q[4 * i + 2] * kx.z + q[4 * i + 3] * kx.w; }
            s = d * 0.125f; }
        sc[ks] = s; }
    const float sink = A->in[11][l * HQB + hq];
    const float m = fmaxf(wave_max(fmaxf(sc[0], sc[1])), sink);
    const float p0 = __expf(sc[0] - m), p1 = __expf(sc[1] - m);
    const float denom = wave_sum(p0 + p1) + __expf(sink - m);
    float o = 0.f;
#pragma unroll 8
    for (int jj = 0; jj < 128; ++jj) { const float pj = __shfl(jj < 64 ? p0 : p1, jj & 63); float vv = 0.f;
        if (isP) { if (pos - 127 + jj >= 0) vv = bf2f(PROJ[(size_t)(row - 127 + jj) * NPROJ + C_VB + kvh * 64 + lane]); }
        else { const int e = pos + 1 + jj; if (e < WIN) vv = cv[((size_t)e * HKVB + kvh) * HDB + lane]; else vv = bf2f(PROJ[(size_t)(TP + bs * DECS + (e - WIN)) * NPROJ + C_VB + kvh * 64 + lane]); }
        o += pj * vv; }
    MIXED[(size_t)row * DM + 512 + hq * 64 + lane] = (bf16)f2bf(o / denom);
}

__device__ __forceinline__ void cache_out(KA A, int l, int bid, int G, int tid) {
    asm volatile("" : "+v"(tid));
    const bf16* PROJ = (const bf16*)(A->ws + WS_PROJ);
    const int gt = bid * NTHREADS + tid, NT = G * NTHREADS;
    for (int i = gt; i < BATCH * WIN * 256; i += NT) { const int c = i & 255, j = (i >> 8) & 127, b = i >> 15;
        const float val = bf2f(PROJ[(size_t)(b * SEQ + SEQ - WIN + j) * NPROJ + C_KB + c]);
        const size_t o = (((size_t)l * BATCH + b) * WIN + j) * 128;
        if (c < 128) A->out[O_KP + o + c] = val; else A->out[O_VP + o + (c - 128)] = val; }
    for (int i = gt; i < DECB * WIN * 64; i += NT) { const int c4 = i & 31, kv = (i >> 5) & 1, j = (i >> 6) & 127, b = i >> 13;
        f32x4 val;
        if (j < WIN - DECS) { const float* src = (kv ? A->in[5] : A->in[4]) + (((size_t)l * DECB + b) * WIN + (j + DECS)) * 128 + c4 * 4; val = *(const f32x4*)src; }
        else { const bf16* src = PROJ + (size_t)(TP + b * DECS + (j - (WIN - DECS))) * NPROJ + (kv ? C_VB : C_KB) + c4 * 4; const v2u w = *(const v2u*)src; val = (f32x4){bflo(w.x), bfhi(w.x), bflo(w.y), bfhi(w.y)}; }
        *(f32x4*)(A->out + (kv ? O_VS : O_KS) + (((size_t)l * DECB + b) * WIN + j) * 128 + c4 * 4) = val; }
}

__device__ __forceinline__ void ph_mix_naive(KA A, int l, LAS unsigned char* lds, int bid, int G, int tid) {
    asm volatile("" : "+v"(tid));
    const int wave = __builtin_amdgcn_readfirstlane(tid >> 6), lane = tid & 63;
    for (int u = bid; u < 32 + DECB * HA; u += G) delta_naive_unit(A, l, u, lds, tid);
    for (int u = bid * NWAVES + wave; u < TT * HQB; u += G * NWAVES) swa_naive_unit(A, l, u >> 3, u & 7, lane);
    cache_out(A, l, bid, G, tid);
}

__device__ __forceinline__ void ph_gate(KA A, int l, int bid, int G, int tid) {
    asm volatile("" : "+v"(tid));
    const int wave = __builtin_amdgcn_readfirstlane(tid >> 6), lane = tid & 63; const int h = lane >> 4, d8 = (lane & 15) * 8;
    const float* OA = (const float*)(A->ws + WS_OA); const bf16* PROJ = (const bf16*)(A->ws + WS_PROJ); bf16* MIXED = (bf16*)(A->ws + WS_MIXED);
    const float* nw = A->in[10] + l * DVA + d8; const f32x4 n0 = *(const f32x4*)nw, n1 = *(const f32x4*)(nw + 4);
    const float nwv[8] = {n0.x, n0.y, n0.z, n0.w, n1.x, n1.y, n1.z, n1.w};
    for (int row = bid * NWAVES + wave; row < TT; row += G * NWAVES) {
        const float* op = OA + (size_t)row * 512 + h * 128 + d8; const f32x4 a0 = *(const f32x4*)op, a1 = *(const f32x4*)(op + 4);
        float o[8] = {a0.x, a0.y, a0.z, a0.w, a1.x, a1.y, a1.z, a1.w};
        float ss = 0.f;
#pragma unroll
        for (int j = 0; j < 8; ++j) ss += o[j] * o[j];
        ss += __shfl_xor(ss, 1); ss += __shfl_xor(ss, 2); ss += __shfl_xor(ss, 4); ss += __shfl_xor(ss, 8);
        const float rs = 1.0f / sqrtf(ss * (1.0f / 128.0f) + EPS);
        float z[8]; unpack8(*(const v4u*)(PROJ + (size_t)row * NPROJ + C_ZA + h * 128 + d8), z);
        float r[8];
#pragma unroll
        for (int j = 0; j < 8; ++j) r[j] = o[j] * rs * nwv[j] * siluf(z[j]);
        v4u w; w.x = pk2(r[0], r[1]); w.y = pk2(r[2], r[3]); w.z = pk2(r[4], r[5]); w.w = pk2(r[6], r[7]);
        *(v4u*)(MIXED + (size_t)row * DM + h * 128 + d8) = w;
    }
}

__device__ __forceinline__ void ph_ln(KA A, const float* gam, const float* bet, int bid, int G, int tid) {
    asm volatile("" : "+v"(tid));
    const int wave = __builtin_amdgcn_readfirstlane(tid >> 6), lane = tid & 63;
    const float* Y = (const float*)(A->ws + WS_Y); bf16* XB = (bf16*)(A->ws + WS_XB);
    for (int row = bid * NWAVES + wave; row < TT; row += G * NWAVES) {
        const f32x4* y = (const f32x4*)(Y + (size_t)row * DM) + lane; f32x4 v[4]; float s = 0.f;
#pragma unroll
        for (int j = 0; j < 4; ++j) { v[j] = y[64 * j]; s += (v[j].x + v[j].y) + (v[j].z + v[j].w); }
        const float mean = wave_sum(s) * (1.0f / DM); float s2 = 0.f;
#pragma unroll
        for (int j = 0; j < 4; ++j) { v[j] = v[j] - mean; s2 += (v[j].x * v[j].x + v[j].y * v[j].y) + (v[j].z * v[j].z + v[j].w * v[j].w); }
        const float rstd = 1.0f / sqrtf(wave_sum(s2) * (1.0f / DM) + EPS);
        f32x4* xo = (f32x4*)(A->out + (size_t)row * DM) + lane; v2u* xb = (v2u*)(XB + (size_t)row * DM) + lane;
#pragma unroll
        for (int j = 0; j < 4; ++j) { const f32x4 g = ((const f32x4*)gam)[lane + 64 * j], bb = ((const f32x4*)bet)[lane + 64 * j];
            const f32x4 o = v[j] * rstd * g + bb; xo[64 * j] = o; v2u w; w.x = pk2(o.x, o.y); w.y = pk2(o.z, o.w); xb[64 * j] = w; }
    }
}
constexpr int PH_PER_LAYER = 9, N_PHASES = 1 + DEPTH * PH_PER_LAYER;
__global__ void __launch_bounds__(NTHREADS, 2) fwd(Args a) {
    extern __shared__ __attribute__((aligned(16))) unsigned char lds_[];
    LAS unsigned char* lds = (LAS unsigned char*)lds_;
    const int tid = threadIdx.x, bid = blockIdx.x, G = gridDim.x;
    for (int u = tid; u < (LDS_BYTES - LDSCTL_OFF) / 4; u += NTHREADS) ((LAS unsigned*)(lds + LDSCTL_OFF))[u] = 0u;
    __syncthreads();
    gu32* ctl = (gu32*)(a.ws + WS_CTL);
    XcdBarrier bar; bar.bar = (unsigned*)(ctl + CW_BAR); bar.x = 0; bar.st = nullptr;
#if MK_ONE_LAUNCH
    bar = xcd_barrier_post((unsigned*)(ctl + CW_BAR), (volatile LAS unsigned*)(lds + MISC_OFF) + 8);
#endif
    const int ph_lo = a.ph_lo, ph_hi = a.ph_hi;
    for (int ph = ph_lo; ph < ph_hi; ++ph) {
        KA A = (KA)__builtin_amdgcn_kernarg_segment_ptr(); asm volatile("" : "+s"(A));
        bf16* XB = (bf16*)(A->ws + WS_XB); bf16* PROJ = (bf16*)(A->ws + WS_PROJ); bf16* MIXED = (bf16*)(A->ws + WS_MIXED); bf16* HB = (bf16*)(A->ws + WS_H); float* Y = (float*)(A->ws + WS_Y);
        if (ph == 0) ph_prologue(A, lds, bid, G, tid);
        else {
            const int l = (ph - 1) / PH_PER_LAYER, k = (ph - 1) % PH_PER_LAYER;
            const bf16* wl = (const bf16*)(A->ws + WS_W + (size_t)l * WL_STRIDE);
            if (k == 0) {
                pg8::Gemm g{XB, wl + WL_IN / 2, TT, NPROJ, DM}; pg8::StaticOrder S; S.init(TT, NPROJ, G, bid);
                pg8::EpiBf16<0> E{PROJ, NPROJ, nullptr, 0, 0, 1.f};
                pg8::gemm_phase<pg8::EpiBf16<0>, pg8::StaticOrder, true, true>(lds, g, S, E);
            } else if (k == 1) ph_baconv(A, l, lds, bid, G, tid);
            else if (k == 2) ph_mix_naive(A, l, lds, bid, G, tid);
            else if (k == 3) ph_gate(A, l, bid, G, tid);
            else if (k == 4) {
                pg8::Gemm g{MIXED, wl + WL_OUT / 2, TT, DM, DM}; pg8::StaticOrder S; S.init(TT, DM, G, bid);
                pg8::EpiResF32 E{Y, DM, l == 0 ? A->in[0] : A->out, l == 0 ? A->in[1] : A->out + (size_t)TP * DM, TP, ALPHA};
                pg8::gemm_phase<pg8::EpiResF32, pg8::StaticOrder, true, true>(lds, g, S, E);
            } else if (k == 5) ph_ln(A, A->in[13] + l * DM, A->in[14] + l * DM, bid, G, tid);
            else if (k == 6) {
                pg8::Gemm g{XB, wl + WL_FI / 2, TT, NFI, DM}; pg8::StaticOrder S; S.init(TT, NFI, G, bid);
                pg8::EpiSwiGLU E{HB, DFF};
                pg8::gemm_phase<pg8::EpiSwiGLU, pg8::StaticOrder, true, true>(lds, g, S, E);
            } else if (k == 7) {
                pg8::Gemm g{HB, wl + WL_FO / 2, TT, DM, DFF}; pg8::StaticOrder S; S.init(TT, DM, G, bid);
                pg8::EpiResF32 E{Y, DM, A->out, A->out + (size_t)TP * DM, TP, ALPHA};
                pg8::gemm_phase<pg8::EpiResF32, pg8::StaticOrder, true, true>(lds, g, S, E);
            } else ph_ln(A, A->in[17] + l * DM, A->in[18] + l * DM, bid, G, tid);
        }
        if (ph + 1 < ph_hi) {
#if MK_ONE_LAUNCH
            if (ph == ph_lo) { __threadfence(); cg::this_grid().sync(); } else xcd_barrier(bar);
#endif
        }
    }
}

extern "C" void kernel_launch(void* const* d_in, const int* in_sizes, int n_in, void* d_out, int out_size, void* d_ws, size_t ws_size, hipStream_t stream) {
    static int grid = 0;
    if (grid == 0) {
        if (n_in != 19 || (size_t)out_size != O_END || ws_size < WS_END) { fprintf(stderr, "kernel_launch: unexpected shapes: n_in %d out %d ws %zu\n", n_in, out_size, ws_size); grid = -1; return; }
        int dev = 0, cus = 0, per_cu = 0;
        if (hipGetDevice(&dev) != hipSuccess || hipDeviceGetAttribute(&cus, hipDeviceAttributeMultiprocessorCount, dev) != hipSuccess) { grid = -1; return; }
        if (hipFuncSetAttribute((const void*)fwd, hipFuncAttributeMaxDynamicSharedMemorySize, LDS_BYTES) != hipSuccess) { fprintf(stderr, "kernel_launch: hipFuncSetAttribute failed\n"); grid = -1; return; }
        if (hipOccupancyMaxActiveBlocksPerMultiprocessor(&per_cu, (const void*)fwd, NTHREADS, LDS_BYTES) != hipSuccess || per_cu < 1) { fprintf(stderr, "kernel_launch: occupancy query says %d\n", per_cu); per_cu = 1; }
        (void)hipGetLastError();
        grid = cus;
    }
    if (grid < 0) return;
    if (hipMemsetAsync((char*)d_ws + WS_CTL, 0, CTL_ZERO_BYTES, stream) != hipSuccess) { fprintf(stderr, "kernel_launch: memset failed\n"); return; }
    Args a{};
    for (int i = 0; i < 19; ++i) a.in[i] = (const float*)d_in[i];
    a.out = (float*)d_out; a.ws = (unsigned char*)d_ws;
#if MK_ONE_LAUNCH
    a.ph_lo = 0; a.ph_hi = N_PHASES;
    void* args[] = {&a};
    hipError_t e = hipLaunchCooperativeKernel((const void*)fwd, dim3(grid), dim3(NTHREADS), args, LDS_BYTES, stream);
    if (e != hipSuccess) fprintf(stderr, "kernel_launch: cooperative launch failed: %s (grid %d)\n", hipGetErrorString(e), grid);
#else
    for (int ph = 0; ph < N_PHASES; ++ph) { a.ph_lo = ph; a.ph_hi = ph + 1; hipLaunchKernelGGL(fwd, dim3(grid), dim3(NTHREADS), LDS_BYTES, stream, a); }
#endif
}
```

```cpp
#include <hip/hip_runtime.h>
#include <hip/hip_cooperative_groups.h>
#include <cstdio>
#include <cstdint>
namespace pg8 {
#define PG8_LAS __attribute__((address_space(3)))
typedef unsigned short bf16_t;
typedef short bf16x8 __attribute__((ext_vector_type(8)));
typedef float f32x4 __attribute__((ext_vector_type(4)));
typedef unsigned u32x4 __attribute__((ext_vector_type(4)));
constexpr int BM = 256, BK = 64, HALF = 128, HTB = HALF * BK * 2  , STAGE_BYTES = 8 * HTB, NXCD = 8, WGM = 8;

__host__ __device__ __forceinline__ int lds_byte(int r, int c) { const int st = (r >> 4) * 2 + (c >> 5), rr = r & 15, cc = c & 31, ob = rr * 64 + cc * 2; return st * 1024 + (ob ^ (((ob >> 9) & 1) << 5)); }
__host__ __device__ __forceinline__ void stage_rc(int b, int& R, int& C) { const int st = b / 1024, sb = b % 1024, swz = sb ^ (((sb >> 9) & 1) << 5); R = (st >> 1) * 16 + swz / 64; C = (st & 1) * 32 + (swz % 64) / 2; }
__host__ __device__ __forceinline__ int perm32(int rho) { const int n = rho >> 4, i = rho & 15; return 8 * (i >> 2) + 4 * n + (i & 3); }

struct Unit { int pm, pn; };
struct Gemm { const bf16_t* A; const bf16_t* Bt; int M, N, K; };

struct StaticOrder {
    int nM, nN, nwg, G, c;
    __host__ __device__ void init(int M, int N, int G_, int c_) { nM = M / BM; nN = N / BM; nwg = nM * nN; G = G_; c = c_; }
    __host__ __device__ bool next(int i, Unit& u) const {
        const long L = (long)i * G + c; if (L >= nwg) return false;
        int wgid = (int)L; { const int q = nwg / NXCD, r = nwg % NXCD, xcd = wgid % NXCD, off = wgid / NXCD; wgid = (xcd < r ? xcd * (q + 1) : r * (q + 1) + (xcd - r) * q) + off; }
        const int nig = WGM * nN, gid = wgid / nig, fm = gid * WGM, gsz = (nM - fm) < WGM ? (nM - fm) : WGM;
        u.pm = fm + ((wgid % nig) % gsz); u.pn = (wgid % nig) / gsz; return true;
    }
    __device__ __forceinline__ void a_ready(const Unit&) const {}
    __device__ __forceinline__ void done(const Unit&) const {}
};

__device__ __forceinline__ unsigned cvt_pk_bf16(float lo, float hi) { unsigned r; asm volatile("v_cvt_pk_bf16_f32 %0, %1, %2" : "=v"(r) : "v"(lo), "v"(hi)); return r; }
typedef float f32x2 __attribute__((ext_vector_type(2)));
__device__ __forceinline__ f32x2 gelu_pk(f32x2 v) {
    const f32x2 av = __builtin_elementwise_abs(v), d = av * 0.2316418882f + 1.0f;
    f32x2 t; t.x = __builtin_amdgcn_rcpf(d.x); t.y = __builtin_amdgcn_rcpf(d.y);
    f32x2 q = t * 0.5307027145f + (-0.7265760135f); q = q * t + 0.7107068705f; q = q * t + (-0.142248368f); q = q * t + 0.127414796f; q = q * t;
    const f32x2 s = (v * v) * (-0.72134752044f);
    f32x2 e; e.x = __builtin_amdgcn_exp2f(s.x); e.y = __builtin_amdgcn_exp2f(s.y);
    const f32x2 m = v * (q * e), r = v - m;
    f32x2 o; o.x = v.x < 0.f ? m.x : r.x; o.y = v.y < 0.f ? m.y : r.y; return o;
}

template <int ACT  > struct EpiBf16 {
    static constexpr bool PERM = true, AFTER_DRAIN = false; static_assert(ACT == 0 || ACT == 1, "EpiBf16: ACT is 0 (none) or 1 (gelu_pk)");
    bf16_t* O; int ldc; const float* bias; int split_cols; size_t split_stride; float scale0;
    __device__ __forceinline__ void operator()(const f32x4 (&acc)[2][2][4][2], const Unit& u, int wr, int wc, int fr, int fq) const {
        const int row0 = u.pm * BM + wr * 64 + fr; int colt = u.pn * BM; bf16_t* base = O;
        float sc = 1.f; if (split_cols) { const int t = colt / split_cols; base += (size_t)t * split_stride; colt -= t * split_cols; if (t == 0) sc = scale0; }
        const int col0 = colt + wc * 32 + 8 * fq, bcol0 = u.pn * BM + wc * 32 + 8 * fq;
        f32x4 bv[2][2];
#pragma unroll
        for (int bj = 0; bj < 2; ++bj)
#pragma unroll
            for (int n = 0; n < 2; ++n) bv[bj][n] = bias ? *(const f32x4*)(bias + bcol0 + bj * HALF + 4 * n) : (f32x4){0.f, 0.f, 0.f, 0.f};
#pragma unroll
        for (int ai = 0; ai < 2; ++ai)
#pragma unroll
            for (int m = 0; m < 4; ++m) { bf16_t* rowp = base + (size_t)(row0 + ai * HALF + m * 16) * ldc + col0;
#pragma unroll
                for (int bj = 0; bj < 2; ++bj) { f32x4 v0 = acc[ai][bj][m][0] + bv[bj][0], v1 = acc[ai][bj][m][1] + bv[bj][1];
                    if (ACT == 1) { f32x2 a = gelu_pk((f32x2){v0[0], v0[1]}), b = gelu_pk((f32x2){v0[2], v0[3]}), c = gelu_pk((f32x2){v1[0], v1[1]}), d = gelu_pk((f32x2){v1[2], v1[3]});
                        v0 = (f32x4){a.x, a.y, b.x, b.y}; v1 = (f32x4){c.x, c.y, d.x, d.y}; }
                    v0 = v0 * sc; v1 = v1 * sc; u32x4 w; w.x = cvt_pk_bf16(v0[0], v0[1]); w.y = cvt_pk_bf16(v0[2], v0[3]); w.z = cvt_pk_bf16(v1[0], v1[1]); w.w = cvt_pk_bf16(v1[2], v1[3]);
                    *(u32x4*)(rowp + bj * HALF) = w; } }
    }
};

struct PanelStats {
    unsigned* xbuf;
    unsigned* cnt;
    unsigned* tmo;
    int ntn; float eps;
    unsigned code;
    __device__ __forceinline__ bool run(const f32x4 (&v)[2][2][4][2], const Unit& u, int wr, int wc, int fr, int fq, PG8_LAS unsigned char* lds, int wid, int lane) const {
        typedef float f32x2v __attribute__((ext_vector_type(2)));
        PG8_LAS f32x2v* P = (PG8_LAS f32x2v*)lds;
        PG8_LAS f32x2v* S = (PG8_LAS f32x2v*)(lds + 8192);
        PG8_LAS unsigned* flag = (PG8_LAS unsigned*)(lds + 8192 + 2048);
#pragma unroll
        for (int ai = 0; ai < 2; ++ai)
#pragma unroll
            for (int m = 0; m < 4; ++m) {
                float s = 0.f;
#pragma unroll
                for (int bj = 0; bj < 2; ++bj)
#pragma unroll
                    for (int n = 0; n < 2; ++n) { const f32x4 x = v[ai][bj][m][n]; s += (x[0] + x[1]) + (x[2] + x[3]); }
                s += __shfl_xor(s, 16); s += __shfl_xor(s, 32);
                const float mw = s * (1.0f / 64.0f); float q = 0.f;
#pragma unroll
                for (int bj = 0; bj < 2; ++bj)
#pragma unroll
                    for (int n = 0; n < 2; ++n) { const f32x4 d = v[ai][bj][m][n] - mw; q += (d[0] * d[0] + d[1] * d[1]) + (d[2] * d[2] + d[3] * d[3]); }
                q += __shfl_xor(q, 16); q += __shfl_xor(q, 32);
                if (fq == 0) P[(ai * HALF + wr * 64 + m * 16 + fr) * 4 + wc] = (f32x2v){mw, q};
            }
        asm volatile("s_waitcnt lgkmcnt(0)" ::: "memory"); __builtin_amdgcn_s_barrier(); asm volatile("" ::: "memory");
#if defined(BROKEN_EXCHANGE_NO_WAIT)
#warning BROKEN CONTROL BUILD: the row-statistics exchange does not wait; results are wrong by design
        if (blockIdx.x >= 64) { const long long t0_ = clock64(); while (clock64() - t0_ < 60000) __builtin_amdgcn_s_sleep(8); }
#endif
        const int row = wid * 32 + (lane & 31);
        if (lane < 32) {
            const f32x2v a = P[row * 4 + 0], b = P[row * 4 + 1], c = P[row * 4 + 2], d = P[row * 4 + 3];
            const float mt = (a.x + b.x + c.x + d.x) * 0.25f;
            const float da = a.x - mt, db = b.x - mt, dc = c.x - mt, dd = d.x - mt;
            const float m2 = (a.y + b.y) + (c.y + d.y) + 64.0f * ((da * da + db * db) + (dc * dc + dd * dd));
            unsigned long long* slot = (unsigned long long*)xbuf + ((size_t)(u.pm * BM + row) * 4 + u.pn);
            __hip_atomic_store(slot, ((unsigned long long)__float_as_uint(m2) << 32) | __float_as_uint(mt), __ATOMIC_RELAXED, __HIP_MEMORY_SCOPE_AGENT);
        }
        asm volatile("s_waitcnt vmcnt(0)" ::: "memory");
        if (lane == 0) __hip_atomic_fetch_add(cnt + 64 * u.pm, 1u, __ATOMIC_RELAXED, __HIP_MEMORY_SCOPE_AGENT);
        if (wid == 0) {
            bool dead = false; const unsigned long long t0 = __builtin_amdgcn_s_memrealtime(); const unsigned want = 8u * (unsigned)ntn;
            for (;;) {
#if defined(BROKEN_EXCHANGE_NO_WAIT)
                break;
#endif
                if ((unsigned)__builtin_amdgcn_readfirstlane(__hip_atomic_load(cnt + 64 * u.pm, __ATOMIC_RELAXED, __HIP_MEMORY_SCOPE_AGENT)) >= want) break;
                if (__builtin_amdgcn_s_memrealtime() - t0 > 2000000ull) {
                    if (lane == 0) { unsigned expect = 0u; __hip_atomic_compare_exchange_strong(tmo + 1, &expect, code | (unsigned)(u.pm & 0xff), __ATOMIC_RELAXED, __ATOMIC_RELAXED, __HIP_MEMORY_SCOPE_AGENT);
                                     __hip_atomic_store(tmo, 1u, __ATOMIC_RELAXED, __HIP_MEMORY_SCOPE_AGENT); }
                    dead = true; break; }
                __builtin_amdgcn_s_sleep(2);
            }
            __builtin_amdgcn_fence(__ATOMIC_ACQUIRE, "agent");
            if (lane == 0) flag[0] = dead ? 1u : 0u;
        }
        asm volatile("s_waitcnt vmcnt(0) lgkmcnt(0)" ::: "memory"); __builtin_amdgcn_s_barrier(); asm volatile("" ::: "memory");
        const bool bad = flag[0] != 0u;
        if (lane < 32) {
            const unsigned long long* slot = (const unsigned long long*)xbuf + (size_t)(u.pm * BM + row) * 4; float mt[4], m2[4]; float ms = 0.f;
#pragma unroll
            for (int t = 0; t < 4; ++t) { if (t < ntn) { const unsigned long long w = __hip_atomic_load(slot + t, __ATOMIC_RELAXED, __HIP_MEMORY_SCOPE_AGENT); mt[t] = __uint_as_float((unsigned)w); m2[t] = __uint_as_float((unsigned)(w >> 32)); } else { mt[t] = 0.f; m2[t] = 0.f; } ms += mt[t]; }
            const float mean = ms / (float)ntn; float q = 0.f;
#pragma unroll
            for (int t = 0; t < 4; ++t) if (t < ntn) { const float dm = mt[t] - mean; q += m2[t] + 256.0f * dm * dm; }
            S[row] = (f32x2v){mean, 1.0f / sqrtf(q / (256.0f * (float)ntn) + eps)};
        }
        asm volatile("s_waitcnt lgkmcnt(0)" ::: "memory"); __builtin_amdgcn_s_barrier(); asm volatile("" ::: "memory");
        return bad;
    }
};
struct EpiLnRes {
    static constexpr bool PERM = false, AFTER_DRAIN = true;
    const float* base; float* out; int ldc; const float* bias; PanelStats st; unsigned poison;
    __device__ __forceinline__ void fused(f32x4 (&acc)[2][2][4][2], const Unit& u, int wr, int wc, int fr, int fq, PG8_LAS unsigned char* lds, int wid, int lane) const {
        typedef float f32x2v __attribute__((ext_vector_type(2)));
        const PG8_LAS f32x2v* S = (const PG8_LAS f32x2v*)(lds + 8192);
        const int col0 = u.pn * BM + wc * 32 + 4 * fq;
#pragma unroll
        for (int bj = 0; bj < 2; ++bj)
#pragma unroll
            for (int n = 0; n < 2; ++n) { const f32x4 bv = bias ? *(const f32x4*)(bias + col0 + bj * HALF + n * 16) : (f32x4){0.f, 0.f, 0.f, 0.f};
#pragma unroll
                for (int ai = 0; ai < 2; ++ai)
#pragma unroll
                    for (int m = 0; m < 4; ++m) acc[ai][bj][m][n] += bv; }
        f32x4 pre[4][2][2];
#pragma unroll
        for (int m = 0; m < 4; ++m) { const size_t off = (size_t)(u.pm * BM + wr * 64 + m * 16 + fr) * ldc + col0;
#pragma unroll
            for (int bj = 0; bj < 2; ++bj)
#pragma unroll
                for (int n = 0; n < 2; ++n) pre[m][bj][n] = *(const f32x4*)(base + off + bj * HALF + n * 16); }
        const bool bad = st.run(acc, u, wr, wc, fr, fq, lds, wid, lane) || poison != 0u;
        const float qnan = __builtin_nanf("");
#pragma unroll
        for (int ai = 0; ai < 2; ++ai)
#pragma unroll
            for (int m = 0; m < 4; ++m) { const int r = ai * HALF + wr * 64 + m * 16 + fr; const f32x2v sr = S[r]; const size_t off = (size_t)(u.pm * BM + r) * ldc + col0;
#pragma unroll
                for (int bj = 0; bj < 2; ++bj)
#pragma unroll
                    for (int n = 0; n < 2; ++n) { const f32x4 bs = ai == 0 ? pre[m][bj][n] : *(const f32x4*)(base + off + bj * HALF + n * 16); f32x4 o = bs + (acc[ai][bj][m][n] - sr.x) * sr.y;
                        if (bad) o = (f32x4){qnan, qnan, qnan, qnan}; *(f32x4*)(out + off + bj * HALF + n * 16) = o; }
                if (m & 1) asm volatile("" ::: "memory"); }
    }
};
struct EpiLnResLn {
    static constexpr bool PERM = false, AFTER_DRAIN = true;
    const float* base; float* out; bf16_t* xn; int ldc; const float* bias; PanelStats st1, st2; unsigned poison;
    __device__ __forceinline__ void fused(f32x4 (&acc)[2][2][4][2], const Unit& u, int wr, int wc, int fr, int fq, PG8_LAS unsigned char* lds, int wid, int lane) const {
        typedef float f32x2v __attribute__((ext_vector_type(2))); typedef unsigned u32x2v __attribute__((ext_vector_type(2)));
        const PG8_LAS f32x2v* S = (const PG8_LAS f32x2v*)(lds + 8192);
        const int col0 = u.pn * BM + wc * 32 + 4 * fq;
#pragma unroll
        for (int bj = 0; bj < 2; ++bj)
#pragma unroll
            for (int n = 0; n < 2; ++n) { const f32x4 bv = bias ? *(const f32x4*)(bias + col0 + bj * HALF + n * 16) : (f32x4){0.f, 0.f, 0.f, 0.f};
#pragma unroll
                for (int ai = 0; ai < 2; ++ai)
#pragma unroll
                    for (int m = 0; m < 4; ++m) acc[ai][bj][m][n] += bv; }
        bool bad = st1.run(acc, u, wr, wc, fr, fq, lds, wid, lane) || poison != 0u;
        const float qnan = __builtin_nanf("");
#pragma unroll
        for (int ai = 0; ai < 2; ++ai)
#pragma unroll
            for (int m = 0; m < 4; ++m) { const int r = ai * HALF + wr * 64 + m * 16 + fr; const f32x2v sr = S[r]; const size_t off = (size_t)(u.pm * BM + r) * ldc + col0;
#pragma unroll
                for (int bj = 0; bj < 2; ++bj)
#pragma unroll
                    for (int n = 0; n < 2; ++n) { const f32x4 bs = *(const f32x4*)(base + off + bj * HALF + n * 16); acc[ai][bj][m][n] = bs + (acc[ai][bj][m][n] - sr.x) * sr.y; }
                asm volatile("" : "+v"(acc[ai][0][m][0]), "+v"(acc[ai][0][m][1]), "+v"(acc[ai][1][m][0]), "+v"(acc[ai][1][m][1]));
                if (m & 1) asm volatile("" ::: "memory"); }
        const bool bad1 = bad;
        bad = st2.run(acc, u, wr, wc, fr, fq, lds, wid, lane) || bad;
#pragma unroll
        for (int ai = 0; ai < 2; ++ai)
#pragma unroll
            for (int m = 0; m < 4; ++m) { const int r = ai * HALF + wr * 64 + m * 16 + fr; const f32x2v sr = S[r]; const size_t off = (size_t)(u.pm * BM + r) * ldc + col0;
#pragma unroll
                for (int bj = 0; bj < 2; ++bj)
#pragma unroll
                    for (int n = 0; n < 2; ++n) { const f32x4 x1 = acc[ai][bj][m][n]; *(f32x4*)(out + off + bj * HALF + n * 16) = bad1 ? (f32x4){qnan, qnan, qnan, qnan} : x1;
                        const f32x4 o = (x1 - sr.x) * sr.y; u32x2v w; w.x = cvt_pk_bf16(o[0], o[1]); w.y = cvt_pk_bf16(o[2], o[3]);
                        if (bad) { w.x = 0x7fc07fc0u; w.y = 0x7fc07fc0u; } *(u32x2v*)(xn + off + bj * HALF + n * 16) = w; }
                asm volatile("" ::: "memory"); }
    }
};

struct EpiResF32 {
    static constexpr bool PERM = false, AFTER_DRAIN = false;
    float* C; int ldc; const float* baseP; const float* baseS; int split_row; float alpha;
    __device__ __forceinline__ void operator()(const f32x4 (&acc)[2][2][4][2], const Unit& u, int wr, int wc, int fr, int fq) const {
        const int row0 = u.pm * BM + wr * 64 + fr, col0 = u.pn * BM + wc * 32 + 4 * fq;
#pragma unroll
        for (int ai = 0; ai < 2; ++ai)
#pragma unroll
            for (int m = 0; m < 4; ++m) { const int row = row0 + ai * HALF + m * 16; float* rowp = C + (size_t)row * ldc + col0;
                const float* bp = (row < split_row ? baseP + (size_t)row * ldc : baseS + (size_t)(row - split_row) * ldc) + col0;
#pragma unroll
                for (int bj = 0; bj < 2; ++bj)
#pragma unroll
                    for (int n = 0; n < 2; ++n) { const f32x4 b = *(const f32x4*)(bp + bj * HALF + n * 16); *(f32x4*)(rowp + bj * HALF + n * 16) = acc[ai][bj][m][n] + b * alpha; } }
    }
};
struct EpiSwiGLU {
    static constexpr bool PERM = true, AFTER_DRAIN = false;
    bf16_t* O; int ldc;
    __device__ __forceinline__ void operator()(const f32x4 (&acc)[2][2][4][2], const Unit& u, int wr, int wc, int fr, int fq) const {
        const int row0 = u.pm * BM + wr * 64 + fr, col0 = u.pn * HALF + wc * 32 + 8 * fq;
#pragma unroll
        for (int ai = 0; ai < 2; ++ai)
#pragma unroll
            for (int m = 0; m < 4; ++m) { bf16_t* rowp = O + (size_t)(row0 + ai * HALF + m * 16) * ldc + col0;
                float h[8];
#pragma unroll
                for (int n = 0; n < 2; ++n)
#pragma unroll
                    for (int e = 0; e < 4; ++e) { const float g = acc[ai][0][m][n][e], up = acc[ai][1][m][n][e]; h[n * 4 + e] = g * __builtin_amdgcn_rcpf(1.0f + __expf(-g)) * up; }
                u32x4 w; w.x = cvt_pk_bf16(h[0], h[1]); w.y = cvt_pk_bf16(h[2], h[3]); w.z = cvt_pk_bf16(h[4], h[5]); w.w = cvt_pk_bf16(h[6], h[7]);
                *(u32x4*)rowp = w; }
    }
};
template <class Epi, class Sched, bool ALIGN_EPI = false, bool SP2 = false>
__device__ __forceinline__ void gemm_phase(PG8_LAS unsigned char* lds, const Gemm g, const Sched& S, const Epi& E) {
    int tid_l = threadIdx.x; asm volatile("" : "+v"(tid_l));
    const int tid = tid_l, wid = __builtin_amdgcn_readfirstlane(tid >> 6), lane = tid & 63, wr = wid >> 2, wc = wid & 3, fr = lane & 15, fq = lane >> 4;
    const int K = g.K, nt = K / BK;
    unsigned voffA[2], voffB[2];
#pragma unroll
    for (int i = 0; i < 2; ++i) { int R, C; stage_rc(tid * 16 + i * 8192, R, C); const int Rb = Epi::PERM ? ((R & ~31) + perm32(R & 31)) : R;
        voffA[i] = (unsigned)(R * K + C) * 2u; voffB[i] = (unsigned)(Rb * K + C) * 2u; }
    const size_t kstep = (size_t)(BK * 2);
    const size_t hstep = (size_t)HALF * K * 2;
    const size_t tstep = 2 * hstep;
    const unsigned ldsw = (unsigned)wid * 1024u;
    const int aoff = lds_byte(wr * 64 + fr, fq * 8), boff = lds_byte(wc * 32 + fr, fq * 8);
#define PG8_SA(b, h) (((b) * 2 + (h)) * HTB)
#define PG8_SB(b, h) ((4 + (b) * 2 + (h)) * HTB)
#define PG8_STAGE(bufoff, gbase, voff) do { _Pragma("unroll") for (int _i = 0; _i < 2; ++_i) \
        __builtin_amdgcn_global_load_lds((const unsigned*)((const char*)(gbase) + (voff)[_i]), (PG8_LAS unsigned*)(lds + (bufoff) + ldsw + _i * 8192), 16, 0, 0); } while (0)
#define PG8_LDA(dst, b, h) do { _Pragma("unroll") for (int m = 0; m < 4; ++m) _Pragma("unroll") for (int k = 0; k < 2; ++k) dst[m][k] = *(const PG8_LAS bf16x8*)(lds + PG8_SA(b, h) + aoff + m * 2048 + k * 1024); } while (0)
#define PG8_LDB(dst, b, h) do { _Pragma("unroll") for (int n = 0; n < 2; ++n) _Pragma("unroll") for (int k = 0; k < 2; ++k) dst[n][k] = *(const PG8_LAS bf16x8*)(lds + PG8_SB(b, h) + boff + n * 2048 + k * 1024); } while (0)
#define PG8_MMA(ai, bj, At, Bt) do { __builtin_amdgcn_s_setprio(1); _Pragma("unroll") for (int m = 0; m < 4; ++m) _Pragma("unroll") for (int n = 0; n < 2; ++n) _Pragma("unroll") for (int k = 0; k < 2; ++k) \
        acc[ai][bj][m][n] = __builtin_amdgcn_mfma_f32_16x16x32_bf16(Bt[n][k], At[m][k], acc[ai][bj][m][n], 0, 0, 0); __builtin_amdgcn_s_setprio(0); } while (0)
#define PG8_WAIT_V(n) asm volatile("s_waitcnt vmcnt(" #n ")" ::: "memory")
#define PG8_WAIT_L(n) asm volatile("s_waitcnt lgkmcnt(" #n ")" ::: "memory")
#define PG8_BAR __builtin_amdgcn_s_barrier()
#define PG8_SCHED __builtin_amdgcn_sched_barrier(0)
    Unit cur, nxt; int ui = 0;
    if (!S.next(0, cur)) return;
    f32x4 acc[2][2][4][2];
#pragma unroll
    for (int a = 0; a < 2; ++a)
#pragma unroll
        for (int b = 0; b < 2; ++b)
#pragma unroll
            for (int m = 0; m < 4; ++m)
#pragma unroll
                for (int n = 0; n < 2; ++n) acc[a][b][m][n] = (f32x4){0.f, 0.f, 0.f, 0.f};
    bf16x8 At[4][2], B0[2][2], B1[2][2];
    const char* cA = (const char*)g.A + (size_t)cur.pm * tstep; const char* cB = (const char*)g.Bt + (size_t)cur.pn * tstep;
    S.a_ready(cur);
    if constexpr (SP2) {
        PG8_STAGE(PG8_SB(0, 0), cB, voffB); PG8_STAGE(PG8_SB(0, 1), cB + hstep, voffB); PG8_STAGE(PG8_SA(0, 0), cA, voffA); PG8_STAGE(PG8_SA(0, 1), cA + hstep, voffA);
        if (wr == 1) PG8_BAR;
        PG8_WAIT_V(2); PG8_BAR;
        PG8_STAGE(PG8_SB(1, 0), cB + kstep, voffB); PG8_STAGE(PG8_SA(1, 0), cA + kstep, voffA); PG8_STAGE(PG8_SB(1, 1), cB + hstep + kstep, voffB);
        PG8_WAIT_V(6); PG8_BAR;
    } else {
        PG8_STAGE(PG8_SB(0, 0), cB, voffB); PG8_STAGE(PG8_SA(0, 0), cA, voffA); PG8_STAGE(PG8_SB(0, 1), cB + hstep, voffB); PG8_STAGE(PG8_SA(0, 1), cA + hstep, voffA);
        if (wr == 1) PG8_BAR;
        PG8_WAIT_V(4); PG8_BAR;
        PG8_STAGE(PG8_SB(1, 0), cB + kstep, voffB); PG8_STAGE(PG8_SA(1, 0), cA + kstep, voffA); PG8_STAGE(PG8_SB(1, 1), cB + hstep + kstep, voffB);
        PG8_WAIT_V(6); PG8_BAR;
    }
    for (;;) {
        const bool has_next = S.next(ui + 1, nxt);
        const char* nA = has_next ? (const char*)g.A + (size_t)nxt.pm * tstep : cA; const char* nB = has_next ? (const char*)g.Bt + (size_t)nxt.pn * tstep : cB;
        for (int t = 0; t < nt; t += 2) {
            const bool last = (t == nt - 2);
            const char* a1 = cA + (size_t)(t + 1) * kstep;
            const char* a2 = last ? nA : cA + (size_t)(t + 2) * kstep; const char* b2 = last ? nB : cB + (size_t)(t + 2) * kstep;
            const char* a3 = a2 + kstep; const char* b3 = b2 + kstep;
            if (last && has_next) S.a_ready(nxt);
            if constexpr (SP2) {
            PG8_LDB(B0, 0, 0); PG8_LDB(B1, 0, 1); PG8_SCHED; PG8_LDA(At, 0, 0); PG8_STAGE(PG8_SA(1, 1), a1 + hstep, voffA);
            PG8_WAIT_V(8); PG8_WAIT_L(0); PG8_BAR; PG8_MMA(0, 0, At, B0); PG8_MMA(0, 1, At, B1); PG8_BAR; PG8_SCHED;
            PG8_LDA(At, 0, 1); PG8_STAGE(PG8_SB(0, 0), b2, voffB); PG8_STAGE(PG8_SB(0, 1), b2 + hstep, voffB); PG8_STAGE(PG8_SA(0, 0), a2, voffA);
            PG8_WAIT_V(8); PG8_WAIT_L(0); PG8_BAR; PG8_MMA(1, 0, At, B0); PG8_MMA(1, 1, At, B1); PG8_BAR; PG8_SCHED;
            PG8_LDB(B0, 1, 0); PG8_LDB(B1, 1, 1); PG8_SCHED; PG8_LDA(At, 1, 0); PG8_STAGE(PG8_SA(0, 1), a2 + hstep, voffA);
            PG8_WAIT_V(8); PG8_WAIT_L(0); PG8_BAR; PG8_MMA(0, 0, At, B0); PG8_MMA(0, 1, At, B1); PG8_BAR; PG8_SCHED;
            PG8_LDA(At, 1, 1); PG8_STAGE(PG8_SB(1, 0), b3, voffB); PG8_STAGE(PG8_SB(1, 1), b3 + hstep, voffB); PG8_STAGE(PG8_SA(1, 0), a3, voffA);
            PG8_WAIT_V(8); PG8_WAIT_L(0); PG8_BAR; PG8_MMA(1, 0, At, B0); PG8_MMA(1, 1, At, B1); PG8_BAR; PG8_SCHED;
            } else {
            PG8_LDB(B0, 0, 0); PG8_SCHED; PG8_LDA(At, 0, 0); PG8_STAGE(PG8_SA(1, 1), a1 + hstep, voffA);
            PG8_WAIT_L(8); PG8_BAR; PG8_WAIT_L(0); PG8_MMA(0, 0, At, B0); PG8_BAR; PG8_SCHED;
            PG8_LDB(B1, 0, 1); PG8_STAGE(PG8_SB(0, 0), b2, voffB);
            PG8_BAR; PG8_WAIT_L(0); PG8_MMA(0, 1, At, B1); PG8_BAR;
            PG8_LDA(At, 0, 1); PG8_STAGE(PG8_SA(0, 0), a2, voffA);
            PG8_BAR; PG8_WAIT_L(0); PG8_MMA(1, 0, At, B0); PG8_BAR; PG8_SCHED;
            PG8_STAGE(PG8_SB(0, 1), b2 + hstep, voffB);
            PG8_WAIT_V(6); PG8_BAR; PG8_MMA(1, 1, At, B1); PG8_BAR;
            PG8_LDB(B0, 1, 0); PG8_SCHED; PG8_LDA(At, 1, 0); PG8_STAGE(PG8_SA(0, 1), a2 + hstep, voffA);
            PG8_WAIT_L(8); PG8_BAR; PG8_WAIT_L(0); PG8_MMA(0, 0, At, B0); PG8_BAR; PG8_SCHED;
            PG8_LDB(B1, 1, 1); PG8_STAGE(PG8_SB(1, 0), b3, voffB);
            PG8_BAR; PG8_WAIT_L(0); PG8_MMA(0, 1, At, B1); PG8_BAR;
            PG8_LDA(At, 1, 1); PG8_STAGE(PG8_SA(1, 0), a3, voffA);
            PG8_BAR; PG8_WAIT_L(0); PG8_MMA(1, 0, At, B0); PG8_BAR; PG8_SCHED;
            PG8_STAGE(PG8_SB(1, 1), b3 + hstep, voffB);
            PG8_WAIT_V(6); PG8_BAR; PG8_MMA(1, 1, At, B1); PG8_BAR;
            }
        }
        if constexpr (ALIGN_EPI) { if (wr == 0) PG8_BAR; }
        if constexpr (!Epi::AFTER_DRAIN) { E(acc, cur, wr, wc, fr, fq); S.done(cur); }
        if (!has_next) break;
#pragma unroll
        for (int a = 0; a < 2; ++a)
#pragma unroll
            for (int b = 0; b < 2; ++b)
#pragma unroll
                for (int m = 0; m < 4; ++m)
#pragma unroll
                    for (int n = 0; n < 2; ++n) acc[a][b][m][n] = (f32x4){0.f, 0.f, 0.f, 0.f};
        cur = nxt; cA = nA; cB = nB; ++ui;
        if constexpr (ALIGN_EPI) { if (wr == 1) PG8_BAR; }
    }
    PG8_WAIT_V(0);
    if constexpr (!ALIGN_EPI) { if (wr == 0) PG8_BAR; }
    PG8_BAR;
    if constexpr (Epi::AFTER_DRAIN) { E.fused(acc, cur, wr, wc, fr, fq, lds, wid, lane); S.done(cur); }
#undef PG8_SA
#undef PG8_SB
#undef PG8_STAGE
#undef PG8_LDA
#undef PG8_LDB
#undef PG8_MMA
#undef PG8_WAIT_V
#undef PG8_WAIT_L
#undef PG8_BAR
#undef PG8_SCHED
}
}

#ifndef MK_ONE_LAUNCH
#define MK_ONE_LAUNCH 1
#endif
namespace cg = cooperative_groups;
constexpr int NWAVES = 8, NTHREADS = 512;
constexpr int DM = 1024, BATCH = 8, SEQ = 2048, DECB = 128, DECS = 4, DEPTH = 4;
constexpr int TP = BATCH * SEQ, TS = DECB * DECS, TT = TP + TS;
constexpr int HA = 4, DKA = 128, DVA = 128, CONVD = 1536, HQB = 8, HKVB = 2, HDB = 64, WIN = 128;
constexpr int NPROJ = 2816, NPROJ_SRC = 2824, DFF = 2816, NFI = 5632;
constexpr int C_QA = 0, C_KA = 512, C_VA = 1024, C_ZA = 1536, C_QB = 2048, C_KB = 2560, C_VB = 2688;
constexpr float ALPHA = 1.681792830507429f, EPS = 1e-6f;
constexpr size_t O_YP = 0, O_YS = 16777216, O_DP = 17301504, O_CP = 19398656, O_KP = 19546112, O_VP = 20070400, O_DS = 20594688, O_CS = 54149120, O_KS = 56508416, O_VS = 64897024, O_END = 73285632;
constexpr size_t MiB = 1u << 20;
constexpr size_t WS_CTL = 0, CTL_ZERO_BYTES = 1 * MiB;
constexpr size_t WS_XCH = 1 * MiB;
constexpr size_t WS_W = 4 * MiB, WL_IN = 0, WL_OUT = 5767168, WL_FI = 7864320, WL_FO = 19398656, WL_STRIDE = 25165824;
constexpr size_t WS_WBA = 100 * MiB;
constexpr size_t WS_XB = 104 * MiB;
constexpr size_t WS_PROJ = 138 * MiB;
constexpr size_t WS_H = WS_PROJ;
constexpr size_t WS_MIXED = 230 * MiB;
constexpr size_t WS_QKV = 264 * MiB;
constexpr size_t WS_BG = 364 * MiB;
constexpr size_t WS_OA = 366 * MiB;
constexpr size_t WS_Y = 400 * MiB;
constexpr size_t WS_CH = 400 * MiB;
constexpr size_t WS_GL = 3 * MiB;
constexpr size_t WS_END = 468 * MiB;
constexpr int CW_BAR = 4096;
constexpr int RING_BYTES = 131072, LDSCTL_OFF = RING_BYTES, MISC_OFF = LDSCTL_OFF + 320, LDS_BYTES = 147456;

#define GAS __attribute__((address_space(1)))
#define LAS __attribute__((address_space(3)))
typedef unsigned short bf16;
typedef unsigned v4u __attribute__((ext_vector_type(4)));
typedef unsigned v2u __attribute__((ext_vector_type(2)));
typedef float f32x4 __attribute__((ext_vector_type(4)));
typedef GAS unsigned gu32;
#define RLX_AGENT __ATOMIC_RELAXED, __HIP_MEMORY_SCOPE_AGENT
#define LDS_WAIT() asm volatile("s_waitcnt lgkmcnt(0)" ::: "memory")
#define VM_WAIT() asm volatile("s_waitcnt vmcnt(0)" ::: "memory")
__device__ __forceinline__ unsigned f2bf(float f) { unsigned u = __builtin_bit_cast(unsigned, f); return (u + 0x7fffu + ((u >> 16) & 1u)) >> 16; }
__device__ __forceinline__ unsigned pk2(float lo, float hi) { return f2bf(lo) | (f2bf(hi) << 16); }
__device__ __forceinline__ float bf2f(unsigned short h) { return __builtin_bit_cast(float, (unsigned)h << 16); }
__device__ __forceinline__ float bflo(unsigned w) { return __builtin_bit_cast(float, w << 16); }
__device__ __forceinline__ float bfhi(unsigned w) { return __builtin_bit_cast(float, w & 0xffff0000u); }
__device__ __forceinline__ void unpack8(const v4u w, float* f) { f[0] = bflo(w.x); f[1] = bfhi(w.x); f[2] = bflo(w.y); f[3] = bfhi(w.y); f[4] = bflo(w.z); f[5] = bfhi(w.z); f[6] = bflo(w.w); f[7] = bfhi(w.w); }
__device__ __forceinline__ float siluf(float x) { return x / (1.0f + __expf(-x)); }
__device__ __forceinline__ float wave_sum(float v) {
#pragma unroll
    for (int o = 1; o < 64; o <<= 1) v += __shfl_xor(v, o);
    return v;
}
__device__ __forceinline__ float wave_max(float v) {
#pragma unroll
    for (int o = 1; o < 64; o <<= 1) v = fmaxf(v, __shfl_xor(v, o));
    return v;
}
#define XB_TMO      128
#define XB_XCNT(j)  (256  + 64 * (j))
#define XB_XSUB(j)  (1280 + 64 * (j))
#define XB_XGEN(j)  (2304 + 64 * (j))
#define XB_TOP      3328
#define XB_TOPGEN   3392
#define XCD_BAR_WORDS 3456
#define XB_SPIN_CAP (1u << 18)

__device__ __forceinline__ unsigned xb_ld(unsigned* p)              { return __hip_atomic_load(p, __ATOMIC_RELAXED, __HIP_MEMORY_SCOPE_AGENT); }
__device__ __forceinline__ unsigned xb_add(unsigned* p, unsigned v) { return __hip_atomic_fetch_add(p, v, __ATOMIC_RELAXED, __HIP_MEMORY_SCOPE_AGENT); }
__device__ __forceinline__ unsigned xb_xcc_id() { return (unsigned)__builtin_amdgcn_s_getreg((3 << 11) | 20) & 0xFu; }
#define XB_SPIN(cond, bar) do { unsigned _sp = 0; while (cond) { __builtin_amdgcn_s_sleep(1); \
    if ((++_sp & 255u) == 0u) { if (xb_ld(&(bar)[XB_TMO])) break; if (_sp > XB_SPIN_CAP) { atomicAdd(&(bar)[XB_TMO], 1u); break; } } } } while (0)

struct XcdBarrier {
    unsigned* bar; unsigned x;
    volatile LAS unsigned* st;
};

__device__ __forceinline__ XcdBarrier xcd_barrier_post(unsigned* bar, volatile LAS unsigned* st) {
    XcdBarrier b; b.bar = bar; b.x = xb_xcc_id(); b.st = st;
    if (threadIdx.x == 0) (void)xb_add(&bar[XB_XCNT(b.x)], 1u);
    return b;
}
__device__ __forceinline__ void xcd_barrier_complete(unsigned* bar, unsigned x, unsigned& nloc, unsigned& nx) {
    const unsigned G = gridDim.x * gridDim.y * gridDim.z;
    unsigned sum, cnt, mine, sp = 0u;
    for (;;) {
        sum = 0u; cnt = 0u; mine = 0u;
#pragma unroll
        for (unsigned j = 0; j < 16; ++j) { const unsigned c = xb_ld(&bar[XB_XCNT(j)]); sum += c; cnt += (c > 0u) ? 1u : 0u; mine = (j == x) ? c : mine; }
        if (sum == G) break;
        __builtin_amdgcn_s_sleep(1);
        if ((++sp & 255u) == 0u) { if (xb_ld(&bar[XB_TMO])) break; if (sp > XB_SPIN_CAP) { atomicAdd(&bar[XB_TMO], 1u); break; } }
    }
    nloc = mine > 0u ? mine : 1u; nx = cnt > 0u ? cnt : 1u;
}

__device__ __forceinline__ void xcd_barrier(const XcdBarrier& b) {
    asm volatile("s_waitcnt vmcnt(0)" ::: "memory");
    __syncthreads();
    if (threadIdx.x == 0) {
        unsigned* bar = b.bar;
        __builtin_amdgcn_s_waitcnt(0);
        unsigned nloc = b.st[0], nx = b.st[1];
        if (nloc == 0u) { xcd_barrier_complete(bar, b.x, nloc, nx); b.st[0] = nloc; b.st[1] = nx; }
        const unsigned old = xb_add(&bar[XB_XSUB(b.x)], 1u);
        const unsigned gen = old / nloc;
        if (old + 1u == (gen + 1u) * nloc) {
            __builtin_amdgcn_fence(__ATOMIC_RELEASE, "agent");
            asm volatile("s_waitcnt vmcnt(0)" ::: "memory");
            const unsigned og = xb_add(&bar[XB_TOP], 1u);
            const unsigned tg = og / nx;
            if (og + 1u == (tg + 1u) * nx) xb_add(&bar[XB_TOPGEN], 1u);
            else XB_SPIN(xb_ld(&bar[XB_TOPGEN]) == tg, bar);
            __builtin_amdgcn_fence(__ATOMIC_ACQUIRE, "agent");
            xb_add(&bar[XB_XGEN(b.x)], 1u);
            asm volatile("s_waitcnt vmcnt(0)" ::: "memory");
        } else {
            XB_SPIN(xb_ld(&bar[XB_XGEN(b.x)]) == gen, bar);
            __builtin_amdgcn_fence(__ATOMIC_ACQUIRE, "agent");
            asm volatile("s_waitcnt vmcnt(0)" ::: "memory");
        }
    }
    __syncthreads();
}
struct Args { const float* in[19]; float* out; unsigned char* ws; int ph_lo, ph_hi; };
typedef const __attribute__((address_space(4))) Args* KA;

__device__ __forceinline__ void transpose_item(const float* W, int ldn, int src_col0, int k0, int K, bf16* WT, int dst_row0, LAS float* scr, int lane) {
#pragma unroll 8
    for (int i = 0; i < 32; ++i) { const int kk = 2 * i + (lane >> 5); scr[kk * 33 + (lane & 31)] = W[(size_t)(k0 + kk) * ldn + src_col0 + (lane & 31)]; }
    LDS_WAIT(); asm volatile("" ::: "memory");
    const int c = lane & 7;
#pragma unroll
    for (int j = 0; j < 4; ++j) { const int n = (lane >> 3) + 8 * j; const LAS float* s = scr + (8 * c) * 33 + n;
        v4u o; o.x = pk2(s[0 * 33], s[1 * 33]); o.y = pk2(s[2 * 33], s[3 * 33]); o.z = pk2(s[4 * 33], s[5 * 33]); o.w = pk2(s[6 * 33], s[7 * 33]);
        *(GAS v4u*)(WT + (size_t)(dst_row0 + n) * K + k0 + 8 * c) = o; }
    LDS_WAIT(); asm volatile("" ::: "memory");
}
__device__ __forceinline__ void ph_prologue(KA A, LAS unsigned char* lds, int bid, int G, int tid) {
    asm volatile("" : "+v"(tid));
    const int wave = __builtin_amdgcn_readfirstlane(tid >> 6), lane = tid & 63;
    LAS float* scr = (LAS float*)(lds + wave * 16384);
    const int gw = bid * NWAVES + wave, NGW = G * NWAVES;
    constexpr int I_IN = 16 * 88, I_OUT = 16 * 32, I_FI = 16 * 176, I_FO = 44 * 32, I_L = I_IN + I_OUT + I_FI + I_FO;
    for (int it = gw; it < DEPTH * I_L; it += NGW) {
        const int l = it / I_L; int r = it % I_L;
        bf16* wl = (bf16*)(A->ws + WS_W + (size_t)l * WL_STRIDE);
        if (r < I_IN) { const int kb = r / 88, nb = r % 88, d0 = 32 * nb, s0 = d0 < 2048 ? d0 : d0 + 8;
            transpose_item(A->in[6] + (size_t)l * DM * NPROJ_SRC, NPROJ_SRC, s0, 64 * kb, DM, wl + WL_IN / 2, d0, scr, lane); continue; }
        r -= I_IN;
        if (r < I_OUT) { const int kb = r / 32, nb = r % 32;
            transpose_item(A->in[12] + (size_t)l * DM * DM, DM, 32 * nb, 64 * kb, DM, wl + WL_OUT / 2, 32 * nb, scr, lane); continue; }
        r -= I_OUT;
        if (r < I_FI) { const int kb = r / 176, nb = r % 176, d0 = 32 * nb, s0 = ((d0 >> 7) & 1) * DFF + (d0 >> 8) * 128 + (d0 & 127);
            transpose_item(A->in[15] + (size_t)l * DM * NFI, NFI, s0, 64 * kb, DM, wl + WL_FI / 2, d0, scr, lane); continue; }
        r -= I_FI;
        { const int kb = r / 32, nb = r % 32;
            transpose_item(A->in[16] + (size_t)l * DFF * DM, DM, 32 * nb, 64 * kb, DFF, wl + WL_FO / 2, 32 * nb, scr, lane); }
    }
    { float* wba = (float*)(A->ws + WS_WBA);
      for (int i = bid * NTHREADS + tid; i < DEPTH * 8 * DM; i += G * NTHREADS) { const int l = i >> 13, c = (i >> 10) & 7, k = i & 1023;
          wba[i] = A->in[6][((size_t)l * DM + k) * NPROJ_SRC + 2048 + c]; } }
    { bf16* XB = (bf16*)(A->ws + WS_XB);
      for (int m = gw; m < TT; m += NGW) {
          const float* src = m < TP ? A->in[0] + (size_t)m * DM : A->in[1] + (size_t)(m - TP) * DM;
          const f32x4* xr = (const f32x4*)src + lane; v2u* o8 = (v2u*)(XB + (size_t)m * DM) + lane;
#pragma unroll
          for (int j = 0; j < 4; ++j) { const f32x4 v = xr[64 * j]; v2u w; w.x = pk2(v.x, v.y); w.y = pk2(v.z, v.w); o8[64 * j] = w; } } }
}

__device__ __forceinline__ void ph_baconv(KA A, int l, LAS unsigned char* lds, int bid, int G, int tid) {
    asm volatile("" : "+v"(tid));
    const int wave = __builtin_amdgcn_readfirstlane(tid >> 6), lane = tid & 63;
    LAS float* wl = (LAS float*)lds;
    { const f32x4* wba = (const f32x4*)((const float*)(A->ws + WS_WBA) + (size_t)l * 8192);
      for (int i = tid; i < 2048; i += NTHREADS) ((LAS f32x4*)wl)[i] = wba[i]; }
    __syncthreads();
    const bf16* XB = (const bf16*)(A->ws + WS_XB); const bf16* PROJ = (const bf16*)(A->ws + WS_PROJ);
    float* QKV = (float*)(A->ws + WS_QKV); float* BG = (float*)(A->ws + WS_BG);
    const float* convw = A->in[7] + (size_t)l * 4 * CONVD;
    const int h = lane >> 4, d8 = (lane & 15) * 8;
    for (int row = bid * NWAVES + wave; row < TT; row += G * NWAVES) {
        { const v4u x0 = *(const v4u*)(XB + (size_t)row * DM + lane * 8), x1 = *(const v4u*)(XB + (size_t)row * DM + 512 + lane * 8);
          float xf[16]; unpack8(x0, xf); unpack8(x1, xf + 8);
          float mine = 0.f;
#pragma unroll
          for (int c = 0; c < 8; ++c) { float acc = 0.f;
#pragma unroll
              for (int j = 0; j < 8; ++j) acc += xf[j] * wl[c * 1024 + lane * 8 + j];
#pragma unroll
              for (int j = 0; j < 8; ++j) acc += xf[8 + j] * wl[c * 1024 + 512 + lane * 8 + j];
              acc = wave_sum(acc); if (lane == c) mine = acc; }
          if (lane < 8) { float o;
              if (lane < 4) o = 1.0f / (1.0f + __expf(-mine));
              else { const int hh = lane - 4; float sp = mine + A->in[9][l * 4 + hh]; sp = sp > 20.f ? sp : log1pf(__expf(sp)); o = -__expf(A->in[8][l * 4 + hh]) * sp; }
              BG[(size_t)row * 8 + lane] = o; } }
        const bool isP = row < TP; const int pos = isP ? (row % SEQ) : ((row - TP) % DECS); const int bs = isP ? (row / SEQ) : ((row - TP) / DECS);
#pragma unroll
        for (int sec = 0; sec < 3; ++sec) { const int c0 = sec * 512 + h * 128 + d8;
            float y[8], xlast[8];
#pragma unroll
            for (int j = 0; j < 8; ++j) { y[j] = 0.f; xlast[j] = 0.f; }
#pragma unroll
            for (int jj = 0; jj < 4; ++jj) { const int tp = pos - 3 + jj; float xv[8];
                if (tp >= 0) { const v4u w = *(const v4u*)(PROJ + (size_t)(row - 3 + jj) * NPROJ + c0); unpack8(w, xv); }
                else if (isP) {
#pragma unroll
                    for (int j = 0; j < 8; ++j) xv[j] = 0.f; }
                else { const float* sc = A->in[3] + (((size_t)l * DECB + bs) * 3 + (tp + 3)) * CONVD + c0; const f32x4 a0 = *(const f32x4*)sc, a1 = *(const f32x4*)(sc + 4);
                    xv[0] = a0.x; xv[1] = a0.y; xv[2] = a0.z; xv[3] = a0.w; xv[4] = a1.x; xv[5] = a1.y; xv[6] = a1.z; xv[7] = a1.w; }
                const f32x4 w0 = *(const f32x4*)(convw + jj * CONVD + c0), w1 = *(const f32x4*)(convw + jj * CONVD + c0 + 4);
                y[0] += w0.x * xv[0]; y[1] += w0.y * xv[1]; y[2] += w0.z * xv[2]; y[3] += w0.w * xv[3]; y[4] += w1.x * xv[4]; y[5] += w1.y * xv[5]; y[6] += w1.z * xv[6]; y[7] += w1.w * xv[7];
                if (jj == 3) {
#pragma unroll
                    for (int j = 0; j < 8; ++j) xlast[j] = xv[j]; } }
#pragma unroll
            for (int j = 0; j < 8; ++j) y[j] = siluf(y[j]);
            if (sec < 2) { float ss = 0.f;
#pragma unroll
                for (int j = 0; j < 8; ++j) ss += y[j] * y[j];
                ss += __shfl_xor(ss, 1); ss += __shfl_xor(ss, 2); ss += __shfl_xor(ss, 4); ss += __shfl_xor(ss, 8);
                const float rs = (1.0f / sqrtf(ss + EPS)) * (sec == 0 ? 0.08838834764831845f : 1.0f);
#pragma unroll
                for (int j = 0; j < 8; ++j) y[j] *= rs; }
            float* qd = QKV + (size_t)row * CONVD + c0;
            *(f32x4*)qd = (f32x4){y[0], y[1], y[2], y[3]}; *(f32x4*)(qd + 4) = (f32x4){y[4], y[5], y[6], y[7]};
            float* cd = nullptr;
            if (isP) { if (pos >= SEQ - 3) cd = A->out + O_CP + (((size_t)l * BATCH + bs) * 3 + (pos - (SEQ - 3))) * CONVD + c0; }
            else { if (pos >= 1) cd = A->out + O_CS + (((size_t)l * DECB + bs) * 3 + (pos - 1)) * CONVD + c0; }
            if (cd) { *(f32x4*)cd = (f32x4){xlast[0], xlast[1], xlast[2], xlast[3]}; *(f32x4*)(cd + 4) = (f32x4){xlast[4], xlast[5], xlast[6], xlast[7]}; }
        }
    }
    __syncthreads();
}

__device__ __forceinline__ void delta_naive_unit(KA A, int l, int u, LAS unsigned char* lds, int tid) {
    asm volatile("" : "+v"(tid));
    LAS float* stage = (LAS float*)lds;
    LAS float* part0 = stage + 2 * 392;
    LAS float* part1 = part0 + 512;
    const int dv = tid & 127, grp = tid >> 7, dk0 = grp * 32;
    const bool isP = u < 32; const int uu = isP ? u : u - 32; const int b = uu >> 2, h = uu & 3; const int L = isP ? SEQ : DECS;
    const size_t row0 = isP ? (size_t)b * SEQ : (size_t)TP + (size_t)b * DECS;
    const float* QKV = (const float*)(A->ws + WS_QKV); const float* BG = (const float*)(A->ws + WS_BG); float* OA = (float*)(A->ws + WS_OA);
    float S[32];
    if (isP) {
#pragma unroll
        for (int i = 0; i < 32; ++i) S[i] = 0.f; }
    else { const float* s0 = A->in[2] + ((((size_t)l * DECB + b) * HA + h) * DKA) * DVA;
#pragma unroll
        for (int i = 0; i < 32; ++i) S[i] = s0[(size_t)(dk0 + i) * DVA + dv]; }
#define DN_PREFETCH(t_, buf_) do { const size_t r_ = row0 + (t_); LAS float* s_ = stage + (buf_) * 392; \
        if (tid < 384) s_[tid] = QKV[r_ * CONVD + (tid >> 7) * 512 + h * 128 + (tid & 127)]; \
        else if (tid == 384) s_[384] = __expf(BG[r_ * 8 + 4 + h]); else if (tid == 385) s_[385] = BG[r_ * 8 + h]; } while (0)
    DN_PREFETCH(0, 0);
    __syncthreads();
    for (int t = 0; t < L; ++t) {
        const int cur = t & 1; const LAS float* st = stage + cur * 392;
        if (t + 1 < L) DN_PREFETCH(t + 1, cur ^ 1);
        const float a = st[384], be = st[385], v = st[256 + dv];
        float kk[32], qq[32];
#pragma unroll
        for (int i = 0; i < 32; ++i) { kk[i] = st[128 + dk0 + i]; qq[i] = st[dk0 + i]; }
        float pk = 0.f;
#pragma unroll
        for (int i = 0; i < 32; ++i) pk += kk[i] * S[i];
        part0[grp * 128 + dv] = pk;
        __syncthreads();
        const float kS = (part0[dv] + part0[128 + dv]) + (part0[256 + dv] + part0[384 + dv]);
        const float dl = be * (v - a * kS);
        float po = 0.f;
#pragma unroll
        for (int i = 0; i < 32; ++i) { S[i] = a * S[i] + kk[i] * dl; po += qq[i] * S[i]; }
        part1[grp * 128 + dv] = po;
        __syncthreads();
        if (grp == 0) OA[(row0 + t) * 512 + h * 128 + dv] = (part1[dv] + part1[128 + dv]) + (part1[256 + dv] + part1[384 + dv]);
    }
#undef DN_PREFETCH
    __syncthreads();
    float* dst = (isP ? A->out + O_DP + (((size_t)l * BATCH + b) * HA + h) * DKA * DVA : A->out + O_DS + (((size_t)l * DECB + b) * HA + h) * DKA * DVA);
#pragma unroll
    for (int i = 0; i < 32; ++i) dst[(size_t)(dk0 + i) * DVA + dv] = S[i];
}

__device__ __forceinline__ void swa_naive_unit(KA A, int l, int row, int hq, int lane) {
    const int kvh = hq >> 2;
    const bf16* PROJ = (const bf16*)(A->ws + WS_PROJ); bf16* MIXED = (bf16*)(A->ws + WS_MIXED);
    float q[64];
    { const v4u* qp = (const v4u*)(PROJ + (size_t)row * NPROJ + C_QB + hq * 64);
#pragma unroll
      for (int i = 0; i < 8; ++i) unpack8(qp[i], q + 8 * i); }
    const bool isP = row < TP; const int pos = isP ? (row % SEQ) : ((row - TP) % DECS); const int bs = isP ? (row / SEQ) : ((row - TP) / DECS);
    const float* ck = A->in[4] + ((size_t)l * DECB + bs) * WIN * HKVB * HDB; const float* cv = A->in[5] + ((size_t)l * DECB + bs) * WIN * HKVB * HDB;
    float sc[2];
#pragma unroll
    for (int ks = 0; ks < 2; ++ks) { const int jj = lane + 64 * ks; float s = -INFINITY;
        const bf16* kp = nullptr; const float* kf = nullptr;
        if (isP) { if (pos - 127 + jj >= 0) kp = PROJ + (size_t)(row - 127 + jj) * NPROJ + C_KB + kvh * 64; }
        else { const int e = pos + 1 + jj; if (e < WIN) kf = ck + ((size_t)e * HKVB + kvh) * HDB; else kp = PROJ + (size_t)(TP + bs * DECS + (e - WIN)) * NPROJ + C_KB + kvh * 64; }
        if (kp) { float d = 0.f;
#pragma unroll
            for (int i = 0; i < 8; ++i) { float kx[8]; unpack8(((const v4u*)kp)[i], kx);
#pragma unroll
                for (int j = 0; j < 8; ++j) d += q[8 * i + j] * kx[j]; }
            s = d * 0.125f; }
        else if (kf) { float d = 0.f;
#pragma unroll
            for (int i = 0; i < 16; ++i) { const f32x4 kx = ((const f32x4*)kf)[i]; d += q[4 * i] * kx.x + q[4 * i + 1] * kx.y + q[4 * i + 2] * kx.z + q[4 * i + 3] * kx.w; }
            s = d * 0.125f; }
        sc[ks] = s; }
    const float sink = A->in[11][l * HQB + hq];
    const float m = fmaxf(wave_max(fmaxf(sc[0], sc[1])), sink);
    const float p0 = __expf(sc[0] - m), p1 = __expf(sc[1] - m);
    const float denom = wave_sum(p0 + p1) + __expf(sink - m);
    float o = 0.f;
#pragma unroll 8
    for (int jj = 0; jj < 128; ++jj) { const float pj = __shfl(jj < 64 ? p0 : p1, jj & 63); float vv = 0.f;
        if (isP) { if (pos - 127 + jj >= 0) vv = bf2f(PROJ[(size_t)(row - 127 + jj) * NPROJ + C_VB + kvh * 64 + lane]); }
        else { const int e = pos + 1 + jj; if (e < WIN) vv = cv[((size_t)e * HKVB + kvh) * HDB + lane]; else vv = bf2f(PROJ[(size_t)(TP + bs * DECS + (e - WIN)) * NPROJ + C_VB + kvh * 64 + lane]); }
        o += pj * vv; }
    MIXED[(size_t)row * DM + 512 + hq * 64 + lane] = (bf16)f2bf(o / denom);
}

__device__ __forceinline__ void cache_out(KA A, int l, int bid, int G, int tid) {
    asm volatile("" : "+v"(tid));
    const bf16* PROJ = (const bf16*)(A->ws + WS_PROJ);
    const int gt = bid * NTHREADS + tid, NT = G * NTHREADS;
    for (int i = gt; i < BATCH * WIN * 256; i += NT) { const int c = i & 255, j = (i >> 8) & 127, b = i >> 15;
        const float val = bf2f(PROJ[(size_t)(b * SEQ + SEQ - WIN + j) * NPROJ + C_KB + c]);
        const size_t o = (((size_t)l * BATCH + b) * WIN + j) * 128;
        if (c < 128) A->out[O_KP + o + c] = val; else A->out[O_VP + o + (c - 128)] = val; }
    for (int i = gt; i < DECB * WIN * 64; i += NT) { const int c4 = i & 31, kv = (i >> 5) & 1, j = (i >> 6) & 127, b = i >> 13;
        f32x4 val;
        if (j < WIN - DECS) { const float* src = (kv ? A->in[5] : A->in[4]) + (((size_t)l * DECB + b) * WIN + (j + DECS)) * 128 + c4 * 4; val = *(const f32x4*)src; }
        else { const bf16* src = PROJ + (size_t)(TP + b * DECS + (j - (WIN - DECS))) * NPROJ + (kv ? C_VB : C_KB) + c4 * 4; const v2u w = *(const v2u*)src; val = (f32x4){bflo(w.x), bfhi(w.x), bflo(w.y), bfhi(w.y)}; }
        *(f32x4*)(A->out + (kv ? O_VS : O_KS) + (((size_t)l * DECB + b) * WIN + j) * 128 + c4 * 4) = val; }
}

__device__ __forceinline__ void ph_mix_naive(KA A, int l, LAS unsigned char* lds, int bid, int G, int tid) {
    asm volatile("" : "+v"(tid));
    const int wave = __builtin_amdgcn_readfirstlane(tid >> 6), lane = tid & 63;
    for (int u = bid; u < 32 + DECB * HA; u += G) delta_naive_unit(A, l, u, lds, tid);
    for (int u = bid * NWAVES + wave; u < TT * HQB; u += G * NWAVES) swa_naive_unit(A, l, u >> 3, u & 7, lane);
    cache_out(A, l, bid, G, tid);
}

__device__ __forceinline__ void ph_gate(KA A, int l, int bid, int G, int tid) {
    asm volatile("" : "+v"(tid));
    const int wave = __builtin_amdgcn_readfirstlane(tid >> 6), lane = tid & 63; const int h = lane >> 4, d8 = (lane & 15) * 8;
    const float* OA = (const float*)(A->ws + WS_OA); const bf16* PROJ = (const bf16*)(A->ws + WS_PROJ); bf16* MIXED = (bf16*)(A->ws + WS_MIXED);
    const float* nw = A->in[10] + l * DVA + d8; const f32x4 n0 = *(const f32x4*)nw, n1 = *(const f32x4*)(nw + 4);
    const float nwv[8] = {n0.x, n0.y, n0.z, n0.w, n1.x, n1.y, n1.z, n1.w};
    for (int row = bid * NWAVES + wave; row < TT; row += G * NWAVES) {
        const float* op = OA + (size_t)row * 512 + h * 128 + d8; const f32x4 a0 = *(const f32x4*)op, a1 = *(const f32x4*)(op + 4);
        float o[8] = {a0.x, a0.y, a0.z, a0.w, a1.x, a1.y, a1.z, a1.w};
        float ss = 0.f;
#pragma unroll
        for (int j = 0; j < 8; ++j) ss += o[j] * o[j];
        ss += __shfl_xor(ss, 1); ss += __shfl_xor(ss, 2); ss += __shfl_xor(ss, 4); ss += __shfl_xor(ss, 8);
        const float rs = 1.0f / sqrtf(ss * (1.0f / 128.0f) + EPS);
        float z[8]; unpack8(*(const v4u*)(PROJ + (size_t)row * NPROJ + C_ZA + h * 128 + d8), z);
        float r[8];
#pragma unroll
        for (int j = 0; j < 8; ++j) r[j] = o[j] * rs * nwv[j] * siluf(z[j]);
        v4u w; w.x = pk2(r[0], r[1]); w.y = pk2(r[2], r[3]); w.z = pk2(r[4], r[5]); w.w = pk2(r[6], r[7]);
        *(v4u*)(MIXED + (size_t)row * DM + h * 128 + d8) = w;
    }
}

__device__ __forceinline__ void ph_ln(KA A, const float* gam, const float* bet, int bid, int G, int tid) {
    asm volatile("" : "+v"(tid));
    const int wave = __builtin_amdgcn_readfirstlane(tid >> 6), lane = tid & 63;
    const float* Y = (const float*)(A->ws + WS_Y); bf16* XB = (bf16*)(A->ws + WS_XB);
    for (int row = bid * NWAVES + wave; row < TT; row += G * NWAVES) {
        const f32x4* y = (const f32x4*)(Y + (size_t)row * DM) + lane; f32x4 v[4]; float s = 0.f;
#pragma unroll
        for (int j = 0; j < 4; ++j) { v[j] = y[64 * j]; s += (v[j].x + v[j].y) + (v[j].z + v[j].w); }
        const float mean = wave_sum(s) * (1.0f / DM); float s2 = 0.f;
#pragma unroll
        for (int j = 0; j < 4; ++j) { v[j] = v[j] - mean; s2 += (v[j].x * v[j].x + v[j].y * v[j].y) + (v[j].z * v[j].z + v[j].w * v[j].w); }
        const float rstd = 1.0f / sqrtf(wave_sum(s2) * (1.0f / DM) + EPS);
        f32x4* xo = (f32x4*)(A->out + (size_t)row * DM) + lane; v2u* xb = (v2u*)(XB + (size_t)row * DM) + lane;
#pragma unroll
        for (int j = 0; j < 4; ++j) { const f32x4 g = ((const f32x4*)gam)[lane + 64 * j], bb = ((const f32x4*)bet)[lane + 64 * j];
            const f32x4 o = v[j] * rstd * g + bb; xo[64 * j] = o; v2u w; w.x = pk2(o.x, o.y); w.y = pk2(o.z, o.w); xb[64 * j] = w; }
    }
}
typedef short bf16x8 __attribute__((ext_vector_type(8)));
typedef short v4i16_t __attribute__((ext_vector_type(4)));
__device__ __forceinline__ unsigned cvtpk(float lo, float hi) { unsigned r; asm("v_cvt_pk_bf16_f32 %0, %1, %2" : "=v"(r) : "v"(lo), "v"(hi)); return r; }
__device__ __forceinline__ v4u pack8u(const f32x4 a, const f32x4 b) { v4u w; w.x = cvtpk(a.x, a.y); w.y = cvtpk(a.z, a.w); w.z = cvtpk(b.x, b.y); w.w = cvtpk(b.z, b.w); return w; }
__device__ __forceinline__ bf16x8 pack8(const f32x4 a, const f32x4 b) { return __builtin_bit_cast(bf16x8, pack8u(a, b)); }
#define MFMA16(a_, b_, c_) __builtin_amdgcn_mfma_f32_16x16x32_bf16((a_), (b_), (c_), 0, 0, 0)

__device__ __forceinline__ void prep_unit(KA A, int u, LAS unsigned char* wl, int lane) {
    asm volatile("" : "+v"(lane));
    const int h = u & 3, n = (u >> 2) & 31, b = u >> 7;
    const int lr = lane & 15, lg = lane >> 4;
    const size_t row0 = (size_t)b * SEQ + (size_t)n * 64;
    const float* BG = (const float*)(A->ws + WS_BG);
    const float* qp = (const float*)(A->ws + WS_QKV) + row0 * CONVD + h * 128; const float* kp = qp + 512;
    unsigned char* CH = A->ws + WS_CH + (size_t)((b * 4 + h) * 32 + n) * 65536;
    const float bj = BG[(row0 + lane) * 8 + h];
    float gc = BG[(row0 + lane) * 8 + 4 + h];
#pragma unroll
    for (int d = 1; d < 64; d <<= 1) { const float t = __shfl_up(gc, d); if (lane >= d) gc += t; }
    const float gcl = __shfl(gc, 63);
    bf16x8 Kf[4][4];
#pragma unroll
    for (int mt = 0; mt < 4; ++mt)
#pragma unroll
        for (int ks = 0; ks < 4; ++ks) { const float* p = kp + (size_t)(16 * mt + lr) * CONVD + 32 * ks + 8 * lg; Kf[mt][ks] = pack8(*(const f32x4*)p, *(const f32x4*)(p + 4)); }
    LAS float* AT = (LAS float*)wl;
#pragma unroll
    for (int mi = 0; mi < 4; ++mi)
#pragma unroll
        for (int ni = 0; ni <= mi; ++ni) {
            f32x4 c = {0.f, 0.f, 0.f, 0.f};
#pragma unroll
            for (int ks = 0; ks < 4; ++ks) c = MFMA16(Kf[mi][ks], Kf[ni][ks], c);
            const int j = 16 * ni + lr; const float gcj = __shfl(gc, j);
            f32x4 o;
#pragma unroll
            for (int r = 0; r < 4; ++r) { const int i = 16 * mi + 4 * lg + r; const float gi = __shfl(gc, i), bi = __shfl(bj, i);
                o[r] = (i > j) ? bi * c[r] * __expf(fminf(gi - gcj, 0.f)) : 0.f; }
            *(LAS f32x4*)(AT + j * 64 + 16 * mi + 4 * lg) = o;
        }
    asm volatile("" ::: "memory");
#pragma unroll
    for (int mi = 0; mi < 4; ++mi) {
        bf16x8 Qf[4];
#pragma unroll
        for (int ks = 0; ks < 4; ++ks) { const float* p = qp + (size_t)(16 * mi + lr) * CONVD + 32 * ks + 8 * lg; Qf[ks] = pack8(*(const f32x4*)p, *(const f32x4*)(p + 4)); }
        const int i = 16 * mi + lr; const float gi = __shfl(gc, i);
        f32x4 t[4];
#pragma unroll
        for (int nj = 0; nj < 4; ++nj) {
            f32x4 c = {0.f, 0.f, 0.f, 0.f};
            if (nj <= mi) {
#pragma unroll
                for (int ks = 0; ks < 4; ++ks) c = MFMA16(Kf[nj][ks], Qf[ks], c);
#pragma unroll
                for (int r = 0; r < 4; ++r) { const int j = 16 * nj + 4 * lg + r; const float gj = __shfl(gc, j); c[r] = (i >= j) ? c[r] * __expf(fminf(gi - gj, 0.f)) : 0.f; }
            }
            t[nj] = c;
        }
#pragma unroll
        for (int ks2 = 0; ks2 < 2; ++ks2) *(v4u*)(CH + 57344 + ((mi * 2 + ks2) * 64 + lane) * 16) = pack8u(t[2 * ks2], t[2 * ks2 + 1]);
    }
    asm volatile("" ::: "memory");
    LAS float* Tl = (LAS float*)(wl + 16384);
    for (int j = 0; j < 64; ++j) Tl[j * 64 + lane] = 0.f;
    for (int j = 63; j >= 0; --j) {
        float a0 = 0.f, a1 = 0.f, a2 = 0.f, a3 = 0.f;
        for (int i = ((j + 1) >> 2) << 2; i < 64; i += 4) { const f32x4 a = *(const LAS f32x4*)(AT + j * 64 + i);
            a0 += Tl[i * 64 + lane] * a.x; a1 += Tl[(i + 1) * 64 + lane] * a.y; a2 += Tl[(i + 2) * 64 + lane] * a.z; a3 += Tl[(i + 3) * 64 + lane] * a.w; }
        Tl[j * 64 + lane] = (lane == j) ? 1.0f : -((a0 + a1) + (a2 + a3));
    }
    asm volatile("s_waitcnt lgkmcnt(0)" ::: "memory");
    LAS unsigned char* TR = wl;
    for (int c = 0; c < 8; ++c) { float tv[8];
#pragma unroll
        for (int e = 0; e < 8; ++e) tv[e] = Tl[(8 * c + e) * 64 + lane] * __shfl(bj, 8 * c + e);
        v4u w; w.x = cvtpk(tv[0], tv[1]); w.y = cvtpk(tv[2], tv[3]); w.z = cvtpk(tv[4], tv[5]); w.w = cvtpk(tv[6], tv[7]);
        *(LAS v4u*)(TR + lane * 144 + c * 16) = w; }
    asm volatile("s_waitcnt lgkmcnt(0)" ::: "memory");
#pragma unroll
    for (int mi = 0; mi < 4; ++mi)
#pragma unroll
        for (int ks2 = 0; ks2 < 2; ++ks2) { const LAS unsigned char* rp = TR + (16 * mi + lr) * 144;
            const v2u lo = *(const LAS v2u*)(rp + (32 * ks2 + 4 * lg) * 2), hi = *(const LAS v2u*)(rp + (32 * ks2 + 16 + 4 * lg) * 2);
            v4u w; w.x = lo.x; w.y = lo.y; w.z = hi.x; w.w = hi.y;
            *(v4u*)(CH + 49152 + ((mi * 2 + ks2) * 64 + lane) * 16) = w; }
    asm volatile("" ::: "memory");
#pragma unroll
    for (int mi = 0; mi < 4; ++mi) { const int tok = 16 * mi + lr; const float e = __expf(__shfl(gc, tok));
        asm volatile("" ::: "memory");
#pragma unroll
        for (int ks = 0; ks < 4; ++ks) { const float* p = kp + (size_t)tok * CONVD + 32 * ks + 4 * lg; const float* pq = qp + (size_t)tok * CONVD + 32 * ks + 4 * lg;
            *(v4u*)(CH + ((mi * 4 + ks) * 64 + lane) * 16) = pack8u(*(const f32x4*)p * e, *(const f32x4*)(p + 16) * e);
            *(v4u*)(CH + 16384 + ((mi * 4 + ks) * 64 + lane) * 16) = pack8u(*(const f32x4*)pq * e, *(const f32x4*)(pq + 16) * e); } }
    asm volatile("s_waitcnt lgkmcnt(0)" ::: "memory");
    LAS unsigned char* KD = wl;
#pragma unroll
    for (int mt = 0; mt < 4; ++mt) { const int tok = 16 * mt + lr; const float e = __expf(gcl - __shfl(gc, tok));
        asm volatile("" ::: "memory");
#pragma unroll
        for (int ks = 0; ks < 4; ++ks) { const float* p = kp + (size_t)tok * CONVD + 32 * ks + 8 * lg;
            *(LAS v4u*)(KD + tok * 256 + (32 * ks + 8 * lg) * 2) = pack8u(*(const f32x4*)p * e, *(const f32x4*)(p + 4) * e); } }
    asm volatile("s_waitcnt lgkmcnt(0)" ::: "memory");
    { const int q4 = lr >> 2, p4 = lr & 3;
#pragma unroll
      for (int mi = 0; mi < 8; ++mi)
#pragma unroll
        for (int ks2 = 0; ks2 < 2; ++ks2) {
            const v4i16_t lo = __builtin_amdgcn_ds_read_tr16_b64_v4i16((LAS v4i16_t*)(KD + (32 * ks2 + 4 * lg + q4) * 256 + (16 * mi + 4 * p4) * 2));
            const v4i16_t hi = __builtin_amdgcn_ds_read_tr16_b64_v4i16((LAS v4i16_t*)(KD + (32 * ks2 + 16 + 4 * lg + q4) * 256 + (16 * mi + 4 * p4) * 2));
            const v2u l2 = __builtin_bit_cast(v2u, lo), h2 = __builtin_bit_cast(v2u, hi);
            v4u w; w.x = l2.x; w.y = l2.y; w.z = h2.x; w.w = h2.y;
            *(v4u*)(CH + 32768 + ((mi * 2 + ks2) * 64 + lane) * 16) = w; } }
    if (lane == 0) ((float*)(A->ws + WS_GL))[(b * 4 + h) * 32 + n] = __expf(gcl);
    asm volatile("s_waitcnt lgkmcnt(0)" ::: "memory");
}
__device__ __forceinline__ void ph_prep(KA A, LAS unsigned char* lds, int bid, int G, int tid) {
    asm volatile("" : "+v"(tid));
    const int wave = __builtin_amdgcn_readfirstlane(tid >> 6), lane = tid & 63;
    for (int u = wave * G + bid; u < BATCH * 32 * HA; u += 4 * G) { if (wave < 4) prep_unit(A, u, lds + wave * 32768, lane); }
}

__device__ __forceinline__ void scan_unit(KA A, int l, int bh, LAS unsigned char* lds, int tid) {
    const int w = __builtin_amdgcn_readfirstlane(tid >> 6), lane = tid & 63, lr = lane & 15, lg = lane >> 4;
    const int b = bh >> 2, h = bh & 3;
    const unsigned char* CHb = A->ws + WS_CH + (size_t)bh * 32 * 65536;
    const float* vp = (const float*)(A->ws + WS_QKV) + (size_t)b * SEQ * CONVD + 1024 + h * 128 + 16 * w + lr;
    float* OA = (float*)(A->ws + WS_OA) + (size_t)b * SEQ * 512 + h * 128 + 16 * w + lr;
    const float* GL = (const float*)(A->ws + WS_GL) + bh * 32;
    f32x4 S[8];
#pragma unroll
    for (int i = 0; i < 8; ++i) S[i] = (f32x4){0.f, 0.f, 0.f, 0.f};
#define SC_STAGE(n_, bo_) do { _Pragma("unroll") for (int i_ = 0; i_ < 8; ++i_) \
        __builtin_amdgcn_global_load_lds((const unsigned*)(CHb + (size_t)(n_) * 65536 + (w * 8 + i_) * 1024 + lane * 16), (LAS unsigned*)(lds + (bo_) + (w * 8 + i_) * 1024), 16, 0, 0); } while (0)
#define SC_FR(off_, idx_) (*(const LAS bf16x8*)(fb + (off_) + (idx_) * 1024))
    SC_STAGE(0, 0);
    for (int n = 0; n < 32; ++n) {
        asm volatile("s_waitcnt vmcnt(0)" ::: "memory");
        __syncthreads();
        const int bo = (n & 1) * 65536;
        if (n + 1 < 32) SC_STAGE(n + 1, bo ^ 65536);
        f32x4 Vc[4];
#pragma unroll
        for (int mi = 0; mi < 4; ++mi)
#pragma unroll
            for (int r = 0; r < 4; ++r) Vc[mi][r] = vp[(size_t)(64 * n + 16 * mi + 4 * lg + r) * CONVD];
        const float gl = GL[n];
        bf16x8 Sb[4];
#pragma unroll
        for (int ks = 0; ks < 4; ++ks) Sb[ks] = pack8(S[2 * ks], S[2 * ks + 1]);
        const LAS unsigned char* fb = lds + bo + lane * 16;
        f32x4 R[4];
#pragma unroll
        for (int mi = 0; mi < 4; ++mi) { f32x4 c = {0.f, 0.f, 0.f, 0.f};
#pragma unroll
            for (int ks = 0; ks < 4; ++ks) c = MFMA16(SC_FR(0, mi * 4 + ks), Sb[ks], c);
            R[mi] = Vc[mi] - c; }
        bf16x8 Rb[2]; Rb[0] = pack8(R[0], R[1]); Rb[1] = pack8(R[2], R[3]);
        f32x4 vn[4];
#pragma unroll
        for (int mi = 0; mi < 4; ++mi) { f32x4 c = {0.f, 0.f, 0.f, 0.f};
#pragma unroll
            for (int ks2 = 0; ks2 < 2; ++ks2) c = MFMA16(SC_FR(49152, mi * 2 + ks2), Rb[ks2], c);
            vn[mi] = c; }
        bf16x8 Vb[2]; Vb[0] = pack8(vn[0], vn[1]); Vb[1] = pack8(vn[2], vn[3]);
#pragma unroll
        for (int mi = 0; mi < 4; ++mi) { f32x4 c = {0.f, 0.f, 0.f, 0.f};
#pragma unroll
            for (int ks = 0; ks < 4; ++ks) c = MFMA16(SC_FR(16384, mi * 4 + ks), Sb[ks], c);
#pragma unroll
            for (int ks2 = 0; ks2 < 2; ++ks2) c = MFMA16(SC_FR(57344, mi * 2 + ks2), Vb[ks2], c);
#pragma unroll
            for (int r = 0; r < 4; ++r) OA[(size_t)(64 * n + 16 * mi + 4 * lg + r) * 512] = c[r]; }
#pragma unroll
        for (int mi = 0; mi < 8; ++mi) { f32x4 c = S[mi] * gl;
#pragma unroll
            for (int ks2 = 0; ks2 < 2; ++ks2) c = MFMA16(SC_FR(32768, mi * 2 + ks2), Vb[ks2], c);
            S[mi] = c; }
    }
#undef SC_STAGE
#undef SC_FR
    float* dst = A->out + O_DP + ((size_t)(l * BATCH + b) * HA + h) * DKA * DVA + 16 * w + lr;
#pragma unroll
    for (int mi = 0; mi < 8; ++mi)
#pragma unroll
        for (int r = 0; r < 4; ++r) dst[(size_t)(16 * mi + 4 * lg + r) * DVA] = S[mi][r];
    __syncthreads();
}
__device__ __forceinline__ void ph_scanmix(KA A, int l, LAS unsigned char* lds, int bid, int G, int tid) {
    asm volatile("" : "+v"(tid));
    const int wave = __builtin_amdgcn_readfirstlane(tid >> 6), lane = tid & 63;
    if (bid < 32) { scan_unit(A, l, bid, lds, tid); return; }
    const int b2 = bid - 32, G2 = G - 32;
    for (int u = 32 + b2; u < 32 + DECB * HA; u += G2) delta_naive_unit(A, l, u, lds, tid);
    for (int u = b2 * NWAVES + wave; u < TT * HQB; u += G2 * NWAVES) swa_naive_unit(A, l, u >> 3, u & 7, lane);
    cache_out(A, l, b2, G2, tid);
}
constexpr int PH_PER_LAYER = 10, N_PHASES = 1 + DEPTH * PH_PER_LAYER;
__global__ void __launch_bounds__(NTHREADS, 2) fwd(Args a) {
    extern __shared__ __attribute__((aligned(16))) unsigned char lds_[];
    LAS unsigned char* lds = (LAS unsigned char*)lds_;
    const int tid = threadIdx.x, bid = blockIdx.x, G = gridDim.x;
    for (int u = tid; u < (LDS_BYTES - LDSCTL_OFF) / 4; u += NTHREADS) ((LAS unsigned*)(lds + LDSCTL_OFF))[u] = 0u;
    __syncthreads();
    gu32* ctl = (gu32*)(a.ws + WS_CTL);
    XcdBarrier bar; bar.bar = (unsigned*)(ctl + CW_BAR); bar.x = 0; bar.st = nullptr;
#if MK_ONE_LAUNCH
    bar = xcd_barrier_post((unsigned*)(ctl + CW_BAR), (volatile LAS unsigned*)(lds + MISC_OFF) + 8);
#endif
    const int ph_lo = a.ph_lo, ph_hi = a.ph_hi;
    for (int ph = ph_lo; ph < ph_hi; ++ph) {
        KA A = (KA)__builtin_amdgcn_kernarg_segment_ptr(); asm volatile("" : "+s"(A));
        bf16* XB = (bf16*)(A->ws + WS_XB); bf16* PROJ = (bf16*)(A->ws + WS_PROJ); bf16* MIXED = (bf16*)(A->ws + WS_MIXED); bf16* HB = (bf16*)(A->ws + WS_H); float* Y = (float*)(A->ws + WS_Y);
        if (ph == 0) ph_prologue(A, lds, bid, G, tid);
        else {
            const int l = (ph - 1) / PH_PER_LAYER, k = (ph - 1) % PH_PER_LAYER;
            const bf16* wl = (const bf16*)(A->ws + WS_W + (size_t)l * WL_STRIDE);
            if (k == 0) {
                pg8::Gemm g{XB, wl + WL_IN / 2, TT, NPROJ, DM}; pg8::StaticOrder S; S.init(TT, NPROJ, G, bid);
                pg8::EpiBf16<0> E{PROJ, NPROJ, nullptr, 0, 0, 1.f};
                pg8::gemm_phase<pg8::EpiBf16<0>, pg8::StaticOrder, true, true>(lds, g, S, E);
            } else if (k == 1) ph_baconv(A, l, lds, bid, G, tid);
            else if (k == 2) ph_prep(A, lds, bid, G, tid);
            else if (k == 3) ph_scanmix(A, l, lds, bid, G, tid);
            else if (k == 4) ph_gate(A, l, bid, G, tid);
            else if (k == 5) {
                pg8::Gemm g{MIXED, wl + WL_OUT / 2, TT, DM, DM}; pg8::StaticOrder S; S.init(TT, DM, G, bid);
                pg8::EpiResF32 E{Y, DM, l == 0 ? A->in[0] : A->out, l == 0 ? A->in[1] : A->out + (size_t)TP * DM, TP, ALPHA};
                pg8::gemm_phase<pg8::EpiResF32, pg8::StaticOrder, true, true>(lds, g, S, E);
            } else if (k == 6) ph_ln(A, A->in[13] + l * DM, A->in[14] + l * DM, bid, G, tid);
            else if (k == 7) {
                pg8::Gemm g{XB, wl + WL_FI / 2, TT, NFI, DM}; pg8::StaticOrder S; S.init(TT, NFI, G, bid);
                pg8::EpiSwiGLU E{HB, DFF};
                pg8::gemm_phase<pg8::EpiSwiGLU, pg8::StaticOrder, true, true>(lds, g, S, E);
            } else if (k == 8) {
                pg8::Gemm g{HB, wl + WL_FO / 2, TT, DM, DFF}; pg8::StaticOrder S; S.init(TT, DM, G, bid);
                pg8::EpiResF32 E{Y, DM, A->out, A->out + (size_t)TP * DM, TP, ALPHA};
                pg8::gemm_phase<pg8::EpiResF32, pg8::StaticOrder, true, true>(lds, g, S, E);
            } else ph_ln(A, A->in[17] + l * DM, A->in[18] + l * DM, bid, G, tid);
        }
        if (ph + 1 < ph_hi) {
#if MK_ONE_LAUNCH
            if (ph == ph_lo) { __threadfence(); cg::this_grid().sync(); } else xcd_barrier(bar);
#endif
        }
    }
}

extern "C" void kernel_launch(void* const* d_in, const int* in_sizes, int n_in, void* d_out, int out_size, void* d_ws, size_t ws_size, hipStream_t stream) {
    static int grid = 0;
    if (grid == 0) {
        if (n_in != 19 || (size_t)out_size != O_END || ws_size < WS_END) { fprintf(stderr, "kernel_launch: unexpected shapes: n_in %d out %d ws %zu\n", n_in, out_size, ws_size); grid = -1; return; }
        int dev = 0, cus = 0, per_cu = 0;
        if (hipGetDevice(&dev) != hipSuccess || hipDeviceGetAttribute(&cus, hipDeviceAttributeMultiprocessorCount, dev) != hipSuccess) { grid = -1; return; }
        if (hipFuncSetAttribute((const void*)fwd, hipFuncAttributeMaxDynamicSharedMemorySize, LDS_BYTES) != hipSuccess) { fprintf(stderr, "kernel_launch: hipFuncSetAttribute failed\n"); grid = -1; return; }
        if (hipOccupancyMaxActiveBlocksPerMultiprocessor(&per_cu, (const void*)fwd, NTHREADS, LDS_BYTES) != hipSuccess || per_cu < 1) { fprintf(stderr, "kernel_launch: occupancy query says %d\n", per_cu); per_cu = 1; }
        (void)hipGetLastError();
        grid = cus;
    }
    if (grid < 0) return;
    if (hipMemsetAsync((char*)d_ws + WS_CTL, 0, CTL_ZERO_BYTES, stream) != hipSuccess) { fprintf(stderr, "kernel_launch: memset failed\n"); return; }
    Args a{};
    for (int i = 0; i < 19; ++i) a.in[i] = (const float*)d_in[i];
    a.out = (float*)d_out; a.ws = (unsigned char*)d_ws;
#if MK_ONE_LAUNCH
    a.ph_lo = 0; a.ph_hi = N_PHASES;
    void* args[] = {&a};
    hipError_t e = hipLaunchCooperativeKernel((const void*)fwd, dim3(grid), dim3(NTHREADS), args, LDS_BYTES, stream);
    if (e != hipSuccess) fprintf(stderr, "kernel_launch: cooperative launch failed: %s (grid %d)\n", hipGetErrorString(e), grid);
#else
    for (int ph = 0; ph < N_PHASES; ++ph) { a.ph_lo = ph; a.ph_hi = ph + 1; hipLaunchKernelGGL(fwd, dim3(grid), dim3(NTHREADS), LDS_BYTES, stream, a); }
#endif
}
```

```cpp
#include <hip/hip_runtime.h>
#include <hip/hip_cooperative_groups.h>
#include <cstdio>
#include <cstdint>
namespace pg8 {
#define PG8_LAS __attribute__((address_space(3)))
typedef unsigned short bf16_t;
typedef short bf16x8 __attribute__((ext_vector_type(8)));
typedef float f32x4 __attribute__((ext_vector_type(4)));
typedef unsigned u32x4 __attribute__((ext_vector_type(4)));
constexpr int BM = 256, BK = 64, HALF = 128, HTB = HALF * BK * 2  , STAGE_BYTES = 8 * HTB, NXCD = 8, WGM = 8;

__host__ __device__ __forceinline__ int lds_byte(int r, int c) { const int st = (r >> 4) * 2 + (c >> 5), rr = r & 15, cc = c & 31, ob = rr * 64 + cc * 2; return st * 1024 + (ob ^ (((ob >> 9) & 1) << 5)); }
__host__ __device__ __forceinline__ void stage_rc(int b, int& R, int& C) { const int st = b / 1024, sb = b % 1024, swz = sb ^ (((sb >> 9) & 1) << 5); R = (st >> 1) * 16 + swz / 64; C = (st & 1) * 32 + (swz % 64) / 2; }
__host__ __device__ __forceinline__ int perm32(int rho) { const int n = rho >> 4, i = rho & 15; return 8 * (i >> 2) + 4 * n + (i & 3); }

struct Unit { int pm, pn; };
struct Gemm { const bf16_t* A; const bf16_t* Bt; int M, N, K; };

struct StaticOrder {
    int nM, nN, nwg, G, c;
    __host__ __device__ void init(int M, int N, int G_, int c_) { nM = M / BM; nN = N / BM; nwg = nM * nN; G = G_; c = c_; }
    __host__ __device__ bool next(int i, Unit& u) const {
        const long L = (long)i * G + c; if (L >= nwg) return false;
        int wgid = (int)L; { const int q = nwg / NXCD, r = nwg % NXCD, xcd = wgid % NXCD, off = wgid / NXCD; wgid = (xcd < r ? xcd * (q + 1) : r * (q + 1) + (xcd - r) * q) + off; }
        const int nig = WGM * nN, gid = wgid / nig, fm = gid * WGM, gsz = (nM - fm) < WGM ? (nM - fm) : WGM;
        u.pm = fm + ((wgid % nig) % gsz); u.pn = (wgid % nig) / gsz; return true;
    }
    __device__ __forceinline__ void a_ready(const Unit&) const {}
    __device__ __forceinline__ void done(const Unit&) const {}
};

__device__ __forceinline__ unsigned cvt_pk_bf16(float lo, float hi) { unsigned r; asm volatile("v_cvt_pk_bf16_f32 %0, %1, %2" : "=v"(r) : "v"(lo), "v"(hi)); return r; }
typedef float f32x2 __attribute__((ext_vector_type(2)));
__device__ __forceinline__ f32x2 gelu_pk(f32x2 v) {
    const f32x2 av = __builtin_elementwise_abs(v), d = av * 0.2316418882f + 1.0f;
    f32x2 t; t.x = __builtin_amdgcn_rcpf(d.x); t.y = __builtin_amdgcn_rcpf(d.y);
    f32x2 q = t * 0.5307027145f + (-0.7265760135f); q = q * t + 0.7107068705f; q = q * t + (-0.142248368f); q = q * t + 0.127414796f; q = q * t;
    const f32x2 s = (v * v) * (-0.72134752044f);
    f32x2 e; e.x = __builtin_amdgcn_exp2f(s.x); e.y = __builtin_amdgcn_exp2f(s.y);
    const f32x2 m = v * (q * e), r = v - m;
    f32x2 o; o.x = v.x < 0.f ? m.x : r.x; o.y = v.y < 0.f ? m.y : r.y; return o;
}

template <int ACT  > struct EpiBf16 {
    static constexpr bool PERM = true, AFTER_DRAIN = false; static_assert(ACT == 0 || ACT == 1, "EpiBf16: ACT is 0 (none) or 1 (gelu_pk)");
    bf16_t* O; int ldc; const float* bias; int split_cols; size_t split_stride; float scale0;
    __device__ __forceinline__ void operator()(const f32x4 (&acc)[2][2][4][2], const Unit& u, int wr, int wc, int fr, int fq) const {
        const int row0 = u.pm * BM + wr * 64 + fr; int colt = u.pn * BM; bf16_t* base = O;
        float sc = 1.f; if (split_cols) { const int t = colt / split_cols; base += (size_t)t * split_stride; colt -= t * split_cols; if (t == 0) sc = scale0; }
        const int col0 = colt + wc * 32 + 8 * fq, bcol0 = u.pn * BM + wc * 32 + 8 * fq;
        f32x4 bv[2][2];
#pragma unroll
        for (int bj = 0; bj < 2; ++bj)
#pragma unroll
            for (int n = 0; n < 2; ++n) bv[bj][n] = bias ? *(const f32x4*)(bias + bcol0 + bj * HALF + 4 * n) : (f32x4){0.f, 0.f, 0.f, 0.f};
#pragma unroll
        for (int ai = 0; ai < 2; ++ai)
#pragma unroll
            for (int m = 0; m < 4; ++m) { bf16_t* rowp = base + (size_t)(row0 + ai * HALF + m * 16) * ldc + col0;
#pragma unroll
                for (int bj = 0; bj < 2; ++bj) { f32x4 v0 = acc[ai][bj][m][0] + bv[bj][0], v1 = acc[ai][bj][m][1] + bv[bj][1];
                    if (ACT == 1) { f32x2 a = gelu_pk((f32x2){v0[0], v0[1]}), b = gelu_pk((f32x2){v0[2], v0[3]}), c = gelu_pk((f32x2){v1[0], v1[1]}), d = gelu_pk((f32x2){v1[2], v1[3]});
                        v0 = (f32x4){a.x, a.y, b.x, b.y}; v1 = (f32x4){c.x, c.y, d.x, d.y}; }
                    v0 = v0 * sc; v1 = v1 * sc; u32x4 w; w.x = cvt_pk_bf16(v0[0], v0[1]); w.y = cvt_pk_bf16(v0[2], v0[3]); w.z = cvt_pk_bf16(v1[0], v1[1]); w.w = cvt_pk_bf16(v1[2], v1[3]);
                    *(u32x4*)(rowp + bj * HALF) = w; } }
    }
};

struct PanelStats {
    unsigned* xbuf;
    unsigned* cnt;
    unsigned* tmo;
    int ntn; float eps;
    unsigned code;
    __device__ __forceinline__ bool run(const f32x4 (&v)[2][2][4][2], const Unit& u, int wr, int wc, int fr, int fq, PG8_LAS unsigned char* lds, int wid, int lane) const {
        typedef float f32x2v __attribute__((ext_vector_type(2)));
        PG8_LAS f32x2v* P = (PG8_LAS f32x2v*)lds;
        PG8_LAS f32x2v* S = (PG8_LAS f32x2v*)(lds + 8192);
        PG8_LAS unsigned* flag = (PG8_LAS unsigned*)(lds + 8192 + 2048);
#pragma unroll
        for (int ai = 0; ai < 2; ++ai)
#pragma unroll
            for (int m = 0; m < 4; ++m) {
                float s = 0.f;
#pragma unroll
                for (int bj = 0; bj < 2; ++bj)
#pragma unroll
                    for (int n = 0; n < 2; ++n) { const f32x4 x = v[ai][bj][m][n]; s += (x[0] + x[1]) + (x[2] + x[3]); }
                s += __shfl_xor(s, 16); s += __shfl_xor(s, 32);
                const float mw = s * (1.0f / 64.0f); float q = 0.f;
#pragma unroll
                for (int bj = 0; bj < 2; ++bj)
#pragma unroll
                    for (int n = 0; n < 2; ++n) { const f32x4 d = v[ai][bj][m][n] - mw; q += (d[0] * d[0] + d[1] * d[1]) + (d[2] * d[2] + d[3] * d[3]); }
                q += __shfl_xor(q, 16); q += __shfl_xor(q, 32);
                if (fq == 0) P[(ai * HALF + wr * 64 + m * 16 + fr) * 4 + wc] = (f32x2v){mw, q};
            }
        asm volatile("s_waitcnt lgkmcnt(0)" ::: "memory"); __builtin_amdgcn_s_barrier(); asm volatile("" ::: "memory");
#if defined(BROKEN_EXCHANGE_NO_WAIT)
#warning BROKEN CONTROL BUILD: the row-statistics exchange does not wait; results are wrong by design
        if (blockIdx.x >= 64) { const long long t0_ = clock64(); while (clock64() - t0_ < 60000) __builtin_amdgcn_s_sleep(8); }
#endif
        const int row = wid * 32 + (lane & 31);
        if (lane < 32) {
            const f32x2v a = P[row * 4 + 0], b = P[row * 4 + 1], c = P[row * 4 + 2], d = P[row * 4 + 3];
            const float mt = (a.x + b.x + c.x + d.x) * 0.25f;
            const float da = a.x - mt, db = b.x - mt, dc = c.x - mt, dd = d.x - mt;
            const float m2 = (a.y + b.y) + (c.y + d.y) + 64.0f * ((da * da + db * db) + (dc * dc + dd * dd));
            unsigned long long* slot = (unsigned long long*)xbuf + ((size_t)(u.pm * BM + row) * 4 + u.pn);
            __hip_atomic_store(slot, ((unsigned long long)__float_as_uint(m2) << 32) | __float_as_uint(mt), __ATOMIC_RELAXED, __HIP_MEMORY_SCOPE_AGENT);
        }
        asm volatile("s_waitcnt vmcnt(0)" ::: "memory");
        if (lane == 0) __hip_atomic_fetch_add(cnt + 64 * u.pm, 1u, __ATOMIC_RELAXED, __HIP_MEMORY_SCOPE_AGENT);
        if (wid == 0) {
            bool dead = false; const unsigned long long t0 = __builtin_amdgcn_s_memrealtime(); const unsigned want = 8u * (unsigned)ntn;
            for (;;) {
#if defined(BROKEN_EXCHANGE_NO_WAIT)
                break;
#endif
                if ((unsigned)__builtin_amdgcn_readfirstlane(__hip_atomic_load(cnt + 64 * u.pm, __ATOMIC_RELAXED, __HIP_MEMORY_SCOPE_AGENT)) >= want) break;
                if (__builtin_amdgcn_s_memrealtime() - t0 > 2000000ull) {
                    if (lane == 0) { unsigned expect = 0u; __hip_atomic_compare_exchange_strong(tmo + 1, &expect, code | (unsigned)(u.pm & 0xff), __ATOMIC_RELAXED, __ATOMIC_RELAXED, __HIP_MEMORY_SCOPE_AGENT);
                                     __hip_atomic_store(tmo, 1u, __ATOMIC_RELAXED, __HIP_MEMORY_SCOPE_AGENT); }
                    dead = true; break; }
                __builtin_amdgcn_s_sleep(2);
            }
            __builtin_amdgcn_fence(__ATOMIC_ACQUIRE, "agent");
            if (lane == 0) flag[0] = dead ? 1u : 0u;
        }
        asm volatile("s_waitcnt vmcnt(0) lgkmcnt(0)" ::: "memory"); __builtin_amdgcn_s_barrier(); asm volatile("" ::: "memory");
        const bool bad = flag[0] != 0u;
        if (lane < 32) {
            const unsigned long long* slot = (const unsigned long long*)xbuf + (size_t)(u.pm * BM + row) * 4; float mt[4], m2[4]; float ms = 0.f;
#pragma unroll
            for (int t = 0; t < 4; ++t) { if (t < ntn) { const unsigned long long w = __hip_atomic_load(slot + t, __ATOMIC_RELAXED, __HIP_MEMORY_SCOPE_AGENT); mt[t] = __uint_as_float((unsigned)w); m2[t] = __uint_as_float((unsigned)(w >> 32)); } else { mt[t] = 0.f; m2[t] = 0.f; } ms += mt[t]; }
            const float mean = ms / (float)ntn; float q = 0.f;
#pragma unroll
            for (int t = 0; t < 4; ++t) if (t < ntn) { const float dm = mt[t] - mean; q += m2[t] + 256.0f * dm * dm; }
            S[row] = (f32x2v){mean, 1.0f / sqrtf(q / (256.0f * (float)ntn) + eps)};
        }
        asm volatile("s_waitcnt lgkmcnt(0)" ::: "memory"); __builtin_amdgcn_s_barrier(); asm volatile("" ::: "memory");
        return bad;
    }
};
struct EpiLnRes {
    static constexpr bool PERM = false, AFTER_DRAIN = true;
    const float* base; float* out; int ldc; const float* bias; PanelStats st; unsigned poison;
    __device__ __forceinline__ void fused(f32x4 (&acc)[2][2][4][2], const Unit& u, int wr, int wc, int fr, int fq, PG8_LAS unsigned char* lds, int wid, int lane) const {
        typedef float f32x2v __attribute__((ext_vector_type(2)));
        const PG8_LAS f32x2v* S = (const PG8_LAS f32x2v*)(lds + 8192);
        const int col0 = u.pn * BM + wc * 32 + 4 * fq;
#pragma unroll
        for (int bj = 0; bj < 2; ++bj)
#pragma unroll
            for (int n = 0; n < 2; ++n) { const f32x4 bv = bias ? *(const f32x4*)(bias + col0 + bj * HALF + n * 16) : (f32x4){0.f, 0.f, 0.f, 0.f};
#pragma unroll
                for (int ai = 0; ai < 2; ++ai)
#pragma unroll
                    for (int m = 0; m < 4; ++m) acc[ai][bj][m][n] += bv; }
        f32x4 pre[4][2][2];
#pragma unroll
        for (int m = 0; m < 4; ++m) { const size_t off = (size_t)(u.pm * BM + wr * 64 + m * 16 + fr) * ldc + col0;
#pragma unroll
            for (int bj = 0; bj < 2; ++bj)
#pragma unroll
                for (int n = 0; n < 2; ++n) pre[m][bj][n] = *(const f32x4*)(base + off + bj * HALF + n * 16); }
        const bool bad = st.run(acc, u, wr, wc, fr, fq, lds, wid, lane) || poison != 0u;
        const float qnan = __builtin_nanf("");
#pragma unroll
        for (int ai = 0; ai < 2; ++ai)
#pragma unroll
            for (int m = 0; m < 4; ++m) { const int r = ai * HALF + wr * 64 + m * 16 + fr; const f32x2v sr = S[r]; const size_t off = (size_t)(u.pm * BM + r) * ldc + col0;
#pragma unroll
                for (int bj = 0; bj < 2; ++bj)
#pragma unroll
                    for (int n = 0; n < 2; ++n) { const f32x4 bs = ai == 0 ? pre[m][bj][n] : *(const f32x4*)(base + off + bj * HALF + n * 16); f32x4 o = bs + (acc[ai][bj][m][n] - sr.x) * sr.y;
                        if (bad) o = (f32x4){qnan, qnan, qnan, qnan}; *(f32x4*)(out + off + bj * HALF + n * 16) = o; }
                if (m & 1) asm volatile("" ::: "memory"); }
    }
};
struct EpiLnResLn {
    static constexpr bool PERM = false, AFTER_DRAIN = true;
    const float* base; float* out; bf16_t* xn; int ldc; const float* bias; PanelStats st1, st2; unsigned poison;
    __device__ __forceinline__ void fused(f32x4 (&acc)[2][2][4][2], const Unit& u, int wr, int wc, int fr, int fq, PG8_LAS unsigned char* lds, int wid, int lane) const {
        typedef float f32x2v __attribute__((ext_vector_type(2))); typedef unsigned u32x2v __attribute__((ext_vector_type(2)));
        const PG8_LAS f32x2v* S = (const PG8_LAS f32x2v*)(lds + 8192);
        const int col0 = u.pn * BM + wc * 32 + 4 * fq;
#pragma unroll
        for (int bj = 0; bj < 2; ++bj)
#pragma unroll
            for (int n = 0; n < 2; ++n) { const f32x4 bv = bias ? *(const f32x4*)(bias + col0 + bj * HALF + n * 16) : (f32x4){0.f, 0.f, 0.f, 0.f};
#pragma unroll
                for (int ai = 0; ai < 2; ++ai)
#pragma unroll
                    for (int m = 0; m < 4; ++m) acc[ai][bj][m][n] += bv; }
        bool bad = st1.run(acc, u, wr, wc, fr, fq, lds, wid, lane) || poison != 0u;
        const float qnan = __builtin_nanf("");
#pragma unroll
        for (int ai = 0; ai < 2; ++ai)
#pragma unroll
            for (int m = 0; m < 4; ++m) { const int r = ai * HALF + wr * 64 + m * 16 + fr; const f32x2v sr = S[r]; const size_t off = (size_t)(u.pm * BM + r) * ldc + col0;
#pragma unroll
                for (int bj = 0; bj < 2; ++bj)
#pragma unroll
                    for (int n = 0; n < 2; ++n) { const f32x4 bs = *(const f32x4*)(base + off + bj * HALF + n * 16); acc[ai][bj][m][n] = bs + (acc[ai][bj][m][n] - sr.x) * sr.y; }
                asm volatile("" : "+v"(acc[ai][0][m][0]), "+v"(acc[ai][0][m][1]), "+v"(acc[ai][1][m][0]), "+v"(acc[ai][1][m][1]));
                if (m & 1) asm volatile("" ::: "memory"); }
        const bool bad1 = bad;
        bad = st2.run(acc, u, wr, wc, fr, fq, lds, wid, lane) || bad;
#pragma unroll
        for (int ai = 0; ai < 2; ++ai)
#pragma unroll
            for (int m = 0; m < 4; ++m) { const int r = ai * HALF + wr * 64 + m * 16 + fr; const f32x2v sr = S[r]; const size_t off = (size_t)(u.pm * BM + r) * ldc + col0;
#pragma unroll
                for (int bj = 0; bj < 2; ++bj)
#pragma unroll
                    for (int n = 0; n < 2; ++n) { const f32x4 x1 = acc[ai][bj][m][n]; *(f32x4*)(out + off + bj * HALF + n * 16) = bad1 ? (f32x4){qnan, qnan, qnan, qnan} : x1;
                        const f32x4 o = (x1 - sr.x) * sr.y; u32x2v w; w.x = cvt_pk_bf16(o[0], o[1]); w.y = cvt_pk_bf16(o[2], o[3]);
                        if (bad) { w.x = 0x7fc07fc0u; w.y = 0x7fc07fc0u; } *(u32x2v*)(xn + off + bj * HALF + n * 16) = w; }
                asm volatile("" ::: "memory"); }
    }
};

struct EpiResF32 {
    static constexpr bool PERM = false, AFTER_DRAIN = false;
    float* C; int ldc; const float* baseP; const float* baseS; int split_row; float alpha;
    __device__ __forceinline__ void operator()(const f32x4 (&acc)[2][2][4][2], const Unit& u, int wr, int wc, int fr, int fq) const {
        const int row0 = u.pm * BM + wr * 64 + fr, col0 = u.pn * BM + wc * 32 + 4 * fq;
#pragma unroll
        for (int ai = 0; ai < 2; ++ai)
#pragma unroll
            for (int m = 0; m < 4; ++m) { const int row = row0 + ai * HALF + m * 16; float* rowp = C + (size_t)row * ldc + col0;
                const float* bp = (row < split_row ? baseP + (size_t)row * ldc : baseS + (size_t)(row - split_row) * ldc) + col0;
#pragma unroll
                for (int bj = 0; bj < 2; ++bj)
#pragma unroll
                    for (int n = 0; n < 2; ++n) { const f32x4 b = *(const f32x4*)(bp + bj * HALF + n * 16); *(f32x4*)(rowp + bj * HALF + n * 16) = acc[ai][bj][m][n] + b * alpha; } }
    }
};
struct EpiSwiGLU {
    static constexpr bool PERM = true, AFTER_DRAIN = false;
    bf16_t* O; int ldc;
    __device__ __forceinline__ void operator()(const f32x4 (&acc)[2][2][4][2], const Unit& u, int wr, int wc, int fr, int fq) const {
        const int row0 = u.pm * BM + wr * 64 + fr, col0 = u.pn * HALF + wc * 32 + 8 * fq;
#pragma unroll
        for (int ai = 0; ai < 2; ++ai)
#pragma unroll
            for (int m = 0; m < 4; ++m) { bf16_t* rowp = O + (size_t)(row0 + ai * HALF + m * 16) * ldc + col0;
                float h[8];
#pragma unroll
                for (int n = 0; n < 2; ++n)
#pragma unroll
                    for (int e = 0; e < 4; ++e) { const float g = acc[ai][0][m][n][e], up = acc[ai][1][m][n][e]; h[n * 4 + e] = g * __builtin_amdgcn_rcpf(1.0f + __expf(-g)) * up; }
                u32x4 w; w.x = cvt_pk_bf16(h[0], h[1]); w.y = cvt_pk_bf16(h[2], h[3]); w.z = cvt_pk_bf16(h[4], h[5]); w.w = cvt_pk_bf16(h[6], h[7]);
                *(u32x4*)rowp = w; }
    }
};
template <class Epi, class Sched, bool ALIGN_EPI = false, bool SP2 = false>
__device__ __forceinline__ void gemm_phase(PG8_LAS unsigned char* lds, const Gemm g, const Sched& S, const Epi& E) {
    int tid_l = threadIdx.x; asm volatile("" : "+v"(tid_l));
    const int tid = tid_l, wid = __builtin_amdgcn_readfirstlane(tid >> 6), lane = tid & 63, wr = wid >> 2, wc = wid & 3, fr = lane & 15, fq = lane >> 4;
    const int K = g.K, nt = K / BK;
    unsigned voffA[2], voffB[2];
#pragma unroll
    for (int i = 0; i < 2; ++i) { int R, C; stage_rc(tid * 16 + i * 8192, R, C); const int Rb = Epi::PERM ? ((R & ~31) + perm32(R & 31)) : R;
        voffA[i] = (unsigned)(R * K + C) * 2u; voffB[i] = (unsigned)(Rb * K + C) * 2u; }
    const size_t kstep = (size_t)(BK * 2);
    const size_t hstep = (size_t)HALF * K * 2;
    const size_t tstep = 2 * hstep;
    const unsigned ldsw = (unsigned)wid * 1024u;
    const int aoff = lds_byte(wr * 64 + fr, fq * 8), boff = lds_byte(wc * 32 + fr, fq * 8);
#define PG8_SA(b, h) (((b) * 2 + (h)) * HTB)
#define PG8_SB(b, h) ((4 + (b) * 2 + (h)) * HTB)
#define PG8_STAGE(bufoff, gbase, voff) do { _Pragma("unroll") for (int _i = 0; _i < 2; ++_i) \
        __builtin_amdgcn_global_load_lds((const unsigned*)((const char*)(gbase) + (voff)[_i]), (PG8_LAS unsigned*)(lds + (bufoff) + ldsw + _i * 8192), 16, 0, 0); } while (0)
#define PG8_LDA(dst, b, h) do { _Pragma("unroll") for (int m = 0; m < 4; ++m) _Pragma("unroll") for (int k = 0; k < 2; ++k) dst[m][k] = *(const PG8_LAS bf16x8*)(lds + PG8_SA(b, h) + aoff + m * 2048 + k * 1024); } while (0)
#define PG8_LDB(dst, b, h) do { _Pragma("unroll") for (int n = 0; n < 2; ++n) _Pragma("unroll") for (int k = 0; k < 2; ++k) dst[n][k] = *(const PG8_LAS bf16x8*)(lds + PG8_SB(b, h) + boff + n * 2048 + k * 1024); } while (0)
#define PG8_MMA(ai, bj, At, Bt) do { __builtin_amdgcn_s_setprio(1); _Pragma("unroll") for (int m = 0; m < 4; ++m) _Pragma("unroll") for (int n = 0; n < 2; ++n) _Pragma("unroll") for (int k = 0; k < 2; ++k) \
        acc[ai][bj][m][n] = __builtin_amdgcn_mfma_f32_16x16x32_bf16(Bt[n][k], At[m][k], acc[ai][bj][m][n], 0, 0, 0); __builtin_amdgcn_s_setprio(0); } while (0)
#define PG8_WAIT_V(n) asm volatile("s_waitcnt vmcnt(" #n ")" ::: "memory")
#define PG8_WAIT_L(n) asm volatile("s_waitcnt lgkmcnt(" #n ")" ::: "memory")
#define PG8_BAR __builtin_amdgcn_s_barrier()
#define PG8_SCHED __builtin_amdgcn_sched_barrier(0)
    Unit cur, nxt; int ui = 0;
    if (!S.next(0, cur)) return;
    f32x4 acc[2][2][4][2];
#pragma unroll
    for (int a = 0; a < 2; ++a)
#pragma unroll
        for (int b = 0; b < 2; ++b)
#pragma unroll
            for (int m = 0; m < 4; ++m)
#pragma unroll
                for (int n = 0; n < 2; ++n) acc[a][b][m][n] = (f32x4){0.f, 0.f, 0.f, 0.f};
    bf16x8 At[4][2], B0[2][2], B1[2][2];
    const char* cA = (const char*)g.A + (size_t)cur.pm * tstep; const char* cB = (const char*)g.Bt + (size_t)cur.pn * tstep;
    S.a_ready(cur);
    if constexpr (SP2) {
        PG8_STAGE(PG8_SB(0, 0), cB, voffB); PG8_STAGE(PG8_SB(0, 1), cB + hstep, voffB); PG8_STAGE(PG8_SA(0, 0), cA, voffA); PG8_STAGE(PG8_SA(0, 1), cA + hstep, voffA);
        if (wr == 1) PG8_BAR;
        PG8_WAIT_V(2); PG8_BAR;
        PG8_STAGE(PG8_SB(1, 0), cB + kstep, voffB); PG8_STAGE(PG8_SA(1, 0), cA + kstep, voffA); PG8_STAGE(PG8_SB(1, 1), cB + hstep + kstep, voffB);
        PG8_WAIT_V(6); PG8_BAR;
    } else {
        PG8_STAGE(PG8_SB(0, 0), cB, voffB); PG8_STAGE(PG8_SA(0, 0), cA, voffA); PG8_STAGE(PG8_SB(0, 1), cB + hstep, voffB); PG8_STAGE(PG8_SA(0, 1), cA + hstep, voffA);
        if (wr == 1) PG8_BAR;
        PG8_WAIT_V(4); PG8_BAR;
        PG8_STAGE(PG8_SB(1, 0), cB + kstep, voffB); PG8_STAGE(PG8_SA(1, 0), cA + kstep, voffA); PG8_STAGE(PG8_SB(1, 1), cB + hstep + kstep, voffB);
        PG8_WAIT_V(6); PG8_BAR;
    }
    for (;;) {
        const bool has_next = S.next(ui + 1, nxt);
        const char* nA = has_next ? (const char*)g.A + (size_t)nxt.pm * tstep : cA; const char* nB = has_next ? (const char*)g.Bt + (size_t)nxt.pn * tstep : cB;
        for (int t = 0; t < nt; t += 2) {
            const bool last = (t == nt - 2);
            const char* a1 = cA + (size_t)(t + 1) * kstep;
            const char* a2 = last ? nA : cA + (size_t)(t + 2) * kstep; const char* b2 = last ? nB : cB + (size_t)(t + 2) * kstep;
            const char* a3 = a2 + kstep; const char* b3 = b2 + kstep;
            if (last && has_next) S.a_ready(nxt);
            if constexpr (SP2) {
            PG8_LDB(B0, 0, 0); PG8_LDB(B1, 0, 1); PG8_SCHED; PG8_LDA(At, 0, 0); PG8_STAGE(PG8_SA(1, 1), a1 + hstep, voffA);
            PG8_WAIT_V(8); PG8_WAIT_L(0); PG8_BAR; PG8_MMA(0, 0, At, B0); PG8_MMA(0, 1, At, B1); PG8_BAR; PG8_SCHED;
            PG8_LDA(At, 0, 1); PG8_STAGE(PG8_SB(0, 0), b2, voffB); PG8_STAGE(PG8_SB(0, 1), b2 + hstep, voffB); PG8_STAGE(PG8_SA(0, 0), a2, voffA);
            PG8_WAIT_V(8); PG8_WAIT_L(0); PG8_BAR; PG8_MMA(1, 0, At, B0); PG8_MMA(1, 1, At, B1); PG8_BAR; PG8_SCHED;
            PG8_LDB(B0, 1, 0); PG8_LDB(B1, 1, 1); PG8_SCHED; PG8_LDA(At, 1, 0); PG8_STAGE(PG8_SA(0, 1), a2 + hstep, voffA);
            PG8_WAIT_V(8); PG8_WAIT_L(0); PG8_BAR; PG8_MMA(0, 0, At, B0); PG8_MMA(0, 1, At, B1); PG8_BAR; PG8_SCHED;
            PG8_LDA(At, 1, 1); PG8_STAGE(PG8_SB(1, 0), b3, voffB); PG8_STAGE(PG8_SB(1, 1), b3 + hstep, voffB); PG8_STAGE(PG8_SA(1, 0), a3, voffA);
            PG8_WAIT_V(8); PG8_WAIT_L(0); PG8_BAR; PG8_MMA(1, 0, At, B0); PG8_MMA(1, 1, At, B1); PG8_BAR; PG8_SCHED;
            } else {
            PG8_LDB(B0, 0, 0); PG8_SCHED; PG8_LDA(At, 0, 0); PG8_STAGE(PG8_SA(1, 1), a1 + hstep, voffA);
            PG8_WAIT_L(8); PG8_BAR; PG8_WAIT_L(0); PG8_MMA(0, 0, At, B0); PG8_BAR; PG8_SCHED;
            PG8_LDB(B1, 0, 1); PG8_STAGE(PG8_SB(0, 0), b2, voffB);
            PG8_BAR; PG8_WAIT_L(0); PG8_MMA(0, 1, At, B1); PG8_BAR;
            PG8_LDA(At, 0, 1); PG8_STAGE(PG8_SA(0, 0), a2, voffA);
            PG8_BAR; PG8_WAIT_L(0); PG8_MMA(1, 0, At, B0); PG8_BAR; PG8_SCHED;
            PG8_STAGE(PG8_SB(0, 1), b2 + hstep, voffB);
            PG8_WAIT_V(6); PG8_BAR; PG8_MMA(1, 1, At, B1); PG8_BAR;
            PG8_LDB(B0, 1, 0); PG8_SCHED; PG8_LDA(At, 1, 0); PG8_STAGE(PG8_SA(0, 1), a2 + hstep, voffA);
            PG8_WAIT_L(8); PG8_BAR; PG8_WAIT_L(0); PG8_MMA(0, 0, At, B0); PG8_BAR; PG8_SCHED;
            PG8_LDB(B1, 1, 1); PG8_STAGE(PG8_SB(1, 0), b3, voffB);
            PG8_BAR; PG8_WAIT_L(0); PG8_MMA(0, 1, At, B1); PG8_BAR;
            PG8_LDA(At, 1, 1); PG8_STAGE(PG8_SA(1, 0), a3, voffA);
            PG8_BAR; PG8_WAIT_L(0); PG8_MMA(1, 0, At, B0); PG8_BAR; PG8_SCHED;
            PG8_STAGE(PG8_SB(1, 1), b3 + hstep, voffB);
            PG8_WAIT_V(6); PG8_BAR; PG8_MMA(1, 1, At, B1); PG8_BAR;
            }
        }
        if constexpr (ALIGN_EPI) { if (wr == 0) PG8_BAR; }
        if constexpr (!Epi::AFTER_DRAIN) { E(acc, cur, wr, wc, fr, fq); S.done(cur); }
        if (!has_next) break;
#pragma unroll
        for (int a = 0; a < 2; ++a)
#pragma unroll
            for (int b = 0; b < 2; ++b)
#pragma unroll
                for (int m = 0; m < 4; ++m)
#pragma unroll
                    for (int n = 0; n < 2; ++n) acc[a][b][m][n] = (f32x4){0.f, 0.f, 0.f, 0.f};
        cur = nxt; cA = nA; cB = nB; ++ui;
        if constexpr (ALIGN_EPI) { if (wr == 1) PG8_BAR; }
    }
    PG8_WAIT_V(0);
    if constexpr (!ALIGN_EPI) { if (wr == 0) PG8_BAR; }
    PG8_BAR;
    if constexpr (Epi::AFTER_DRAIN) { E.fused(acc, cur, wr, wc, fr, fq, lds, wid, lane); S.done(cur); }
#undef PG8_SA
#undef PG8_SB
#undef PG8_STAGE
#undef PG8_LDA
#undef PG8_LDB
#undef PG8_MMA
#undef PG8_WAIT_V
#undef PG8_WAIT_L
#undef PG8_BAR
#undef PG8_SCHED
}
}

#ifndef MK_ONE_LAUNCH
#define MK_ONE_LAUNCH 1
#endif
namespace cg = cooperative_groups;
constexpr int NWAVES = 8, NTHREADS = 512;
constexpr int DM = 1024, BATCH = 8, SEQ = 2048, DECB = 128, DECS = 4, DEPTH = 4;
constexpr int TP = BATCH * SEQ, TS = DECB * DECS, TT = TP + TS;
constexpr int HA = 4, DKA = 128, DVA = 128, CONVD = 1536, HQB = 8, HKVB = 2, HDB = 64, WIN = 128;
constexpr int NPROJ = 2816, NPROJ_SRC = 2824, DFF = 2816, NFI = 5632;
constexpr int C_QA = 0, C_KA = 512, C_VA = 1024, C_ZA = 1536, C_QB = 2048, C_KB = 2560, C_VB = 2688;
constexpr float ALPHA = 1.681792830507429f, EPS = 1e-6f;
constexpr size_t O_YP = 0, O_YS = 16777216, O_DP = 17301504, O_CP = 19398656, O_KP = 19546112, O_VP = 20070400, O_DS = 20594688, O_CS = 54149120, O_KS = 56508416, O_VS = 64897024, O_END = 73285632;
constexpr size_t MiB = 1u << 20;
constexpr size_t WS_CTL = 0, CTL_ZERO_BYTES = 1 * MiB;
constexpr size_t WS_XCH = 1 * MiB;
constexpr size_t WS_W = 4 * MiB, WL_IN = 0, WL_OUT = 5767168, WL_FI = 7864320, WL_FO = 19398656, WL_STRIDE = 25165824;
constexpr size_t WS_WBA = 100 * MiB;
constexpr size_t WS_XB = 104 * MiB;
constexpr size_t WS_PROJ = 138 * MiB;
constexpr size_t WS_H = WS_PROJ;
constexpr size_t WS_MIXED = 230 * MiB;
constexpr size_t WS_QKV = 264 * MiB;
constexpr size_t WS_BG = 364 * MiB;
constexpr size_t WS_OA = 366 * MiB;
constexpr size_t WS_Y = 400 * MiB;
constexpr size_t WS_CH = 400 * MiB;
constexpr size_t WS_GL = 3 * MiB;
constexpr size_t WS_END = 468 * MiB;
constexpr int CW_BAR = 4096;
constexpr int RING_BYTES = 131072, LDSCTL_OFF = RING_BYTES, MISC_OFF = LDSCTL_OFF + 320, LDS_BYTES = 147456;

#define GAS __attribute__((address_space(1)))
#define LAS __attribute__((address_space(3)))
typedef unsigned short bf16;
typedef unsigned v4u __attribute__((ext_vector_type(4)));
typedef unsigned v2u __attribute__((ext_vector_type(2)));
typedef float f32x4 __attribute__((ext_vector_type(4)));
typedef GAS unsigned gu32;
#define RLX_AGENT __ATOMIC_RELAXED, __HIP_MEMORY_SCOPE_AGENT
#define LDS_WAIT() asm volatile("s_waitcnt lgkmcnt(0)" ::: "memory")
#define VM_WAIT() asm volatile("s_waitcnt vmcnt(0)" ::: "memory")
__device__ __forceinline__ unsigned f2bf(float f) { unsigned u = __builtin_bit_cast(unsigned, f); return (u + 0x7fffu + ((u >> 16) & 1u)) >> 16; }
__device__ __forceinline__ unsigned pk2(float lo, float hi) { return f2bf(lo) | (f2bf(hi) << 16); }
__device__ __forceinline__ float bf2f(unsigned short h) { return __builtin_bit_cast(float, (unsigned)h << 16); }
__device__ __forceinline__ float bflo(unsigned w) { return __builtin_bit_cast(float, w << 16); }
__device__ __forceinline__ float bfhi(unsigned w) { return __builtin_bit_cast(float, w & 0xffff0000u); }
__device__ __forceinline__ void unpack8(const v4u w, float* f) { f[0] = bflo(w.x); f[1] = bfhi(w.x); f[2] = bflo(w.y); f[3] = bfhi(w.y); f[4] = bflo(w.z); f[5] = bfhi(w.z); f[6] = bflo(w.w); f[7] = bfhi(w.w); }
__device__ __forceinline__ float siluf(float x) { return x / (1.0f + __expf(-x)); }
__device__ __forceinline__ float wave_sum(float v) {
#pragma unroll
    for (int o = 1; o < 64; o <<= 1) v += __shfl_xor(v, o);
    return v;
}
__device__ __forceinline__ float wave_max(float v) {
#pragma unroll
    for (int o = 1; o < 64; o <<= 1) v = fmaxf(v, __shfl_xor(v, o));
    return v;
}
#define XB_TMO      128
#define XB_XCNT(j)  (256  + 64 * (j))
#define XB_XSUB(j)  (1280 + 64 * (j))
#define XB_XGEN(j)  (2304 + 64 * (j))
#define XB_TOP      3328
#define XB_TOPGEN   3392
#define XCD_BAR_WORDS 3456
#define XB_SPIN_CAP (1u << 18)

__device__ __forceinline__ unsigned xb_ld(unsigned* p)              { return __hip_atomic_load(p, __ATOMIC_RELAXED, __HIP_MEMORY_SCOPE_AGENT); }
__device__ __forceinline__ unsigned xb_add(unsigned* p, unsigned v) { return __hip_atomic_fetch_add(p, v, __ATOMIC_RELAXED, __HIP_MEMORY_SCOPE_AGENT); }
__device__ __forceinline__ unsigned xb_xcc_id() { return (unsigned)__builtin_amdgcn_s_getreg((3 << 11) | 20) & 0xFu; }
#define XB_SPIN(cond, bar) do { unsigned _sp = 0; while (cond) { __builtin_amdgcn_s_sleep(1); \
    if ((++_sp & 255u) == 0u) { if (xb_ld(&(bar)[XB_TMO])) break; if (_sp > XB_SPIN_CAP) { atomicAdd(&(bar)[XB_TMO], 1u); break; } } } } while (0)

struct XcdBarrier {
    unsigned* bar; unsigned x;
    volatile LAS unsigned* st;
};

__device__ __forceinline__ XcdBarrier xcd_barrier_post(unsigned* bar, volatile LAS unsigned* st) {
    XcdBarrier b; b.bar = bar; b.x = xb_xcc_id(); b.st = st;
    if (threadIdx.x == 0) (void)xb_add(&bar[XB_XCNT(b.x)], 1u);
    return b;
}
__device__ __forceinline__ void xcd_barrier_complete(unsigned* bar, unsigned x, unsigned& nloc, unsigned& nx) {
    const unsigned G = gridDim.x * gridDim.y * gridDim.z;
    unsigned sum, cnt, mine, sp = 0u;
    for (;;) {
        sum = 0u; cnt = 0u; mine = 0u;
#pragma unroll
        for (unsigned j = 0; j < 16; ++j) { const unsigned c = xb_ld(&bar[XB_XCNT(j)]); sum += c; cnt += (c > 0u) ? 1u : 0u; mine = (j == x) ? c : mine; }
        if (sum == G) break;
        __builtin_amdgcn_s_sleep(1);
        if ((++sp & 255u) == 0u) { if (xb_ld(&bar[XB_TMO])) break; if (sp > XB_SPIN_CAP) { atomicAdd(&bar[XB_TMO], 1u); break; } }
    }
    nloc = mine > 0u ? mine : 1u; nx = cnt > 0u ? cnt : 1u;
}

__device__ __forceinline__ void xcd_barrier(const XcdBarrier& b) {
    asm volatile("s_waitcnt vmcnt(0)" ::: "memory");
    __syncthreads();
    if (threadIdx.x == 0) {
        unsigned* bar = b.bar;
        __builtin_amdgcn_s_waitcnt(0);
        unsigned nloc = b.st[0], nx = b.st[1];
        if (nloc == 0u) { xcd_barrier_complete(bar, b.x, nloc, nx); b.st[0] = nloc; b.st[1] = nx; }
        const unsigned old = xb_add(&bar[XB_XSUB(b.x)], 1u);
        const unsigned gen = old / nloc;
        if (old + 1u == (gen + 1u) * nloc) {
            __builtin_amdgcn_fence(__ATOMIC_RELEASE, "agent");
            asm volatile("s_waitcnt vmcnt(0)" ::: "memory");
            const unsigned og = xb_add(&bar[XB_TOP], 1u);
            const unsigned tg = og / nx;
            if (og + 1u == (tg + 1u) * nx) xb_add(&bar[XB_TOPGEN], 1u);
            else XB_SPIN(xb_ld(&bar[XB_TOPGEN]) == tg, bar);
            __builtin_amdgcn_fence(__ATOMIC_ACQUIRE, "agent");
            xb_add(&bar[XB_XGEN(b.x)], 1u);
            asm volatile("s_waitcnt vmcnt(0)" ::: "memory");
        } else {
            XB_SPIN(xb_ld(&bar[XB_XGEN(b.x)]) == gen, bar);
            __builtin_amdgcn_fence(__ATOMIC_ACQUIRE, "agent");
            asm volatile("s_waitcnt vmcnt(0)" ::: "memory");
        }
    }
    __syncthreads();
}
struct Args { const float* in[19]; float* out; unsigned char* ws; int ph_lo, ph_hi; };
typedef const __attribute__((address_space(4))) Args* KA;

__device__ __forceinline__ void transpose_item(const float* W, int ldn, int src_col0, int k0, int K, bf16* WT, int dst_row0, LAS float* scr, int lane) {
#pragma unroll 8
    for (int i = 0; i < 32; ++i) { const int kk = 2 * i + (lane >> 5); scr[kk * 33 + (lane & 31)] = W[(size_t)(k0 + kk) * ldn + src_col0 + (lane & 31)]; }
    LDS_WAIT(); asm volatile("" ::: "memory");
    const int c = lane & 7;
#pragma unroll
    for (int j = 0; j < 4; ++j) { const int n = (lane >> 3) + 8 * j; const LAS float* s = scr + (8 * c) * 33 + n;
        v4u o; o.x = pk2(s[0 * 33], s[1 * 33]); o.y = pk2(s[2 * 33], s[3 * 33]); o.z = pk2(s[4 * 33], s[5 * 33]); o.w = pk2(s[6 * 33], s[7 * 33]);
        *(GAS v4u*)(WT + (size_t)(dst_row0 + n) * K + k0 + 8 * c) = o; }
    LDS_WAIT(); asm volatile("" ::: "memory");
}
__device__ __forceinline__ void ph_prologue(KA A, LAS unsigned char* lds, int bid, int G, int tid) {
    asm volatile("" : "+v"(tid));
    const int wave = __builtin_amdgcn_readfirstlane(tid >> 6), lane = tid & 63;
    LAS float* scr = (LAS float*)(lds + wave * 16384);
    const int gw = bid * NWAVES + wave, NGW = G * NWAVES;
    constexpr int I_IN = 16 * 88, I_OUT = 16 * 32, I_FI = 16 * 176, I_FO = 44 * 32, I_L = I_IN + I_OUT + I_FI + I_FO;
    for (int it = gw; it < DEPTH * I_L; it += NGW) {
        const int l = it / I_L; int r = it % I_L;
        bf16* wl = (bf16*)(A->ws + WS_W + (size_t)l * WL_STRIDE);
        if (r < I_IN) { const int kb = r / 88, nb = r % 88, d0 = 32 * nb, s0 = d0 < 2048 ? d0 : d0 + 8;
            transpose_item(A->in[6] + (size_t)l * DM * NPROJ_SRC, NPROJ_SRC, s0, 64 * kb, DM, wl + WL_IN / 2, d0, scr, lane); continue; }
        r -= I_IN;
        if (r < I_OUT) { const int kb = r / 32, nb = r % 32;
            transpose_item(A->in[12] + (size_t)l * DM * DM, DM, 32 * nb, 64 * kb, DM, wl + WL_OUT / 2, 32 * nb, scr, lane); continue; }
        r -= I_OUT;
        if (r < I_FI) { const int kb = r / 176, nb = r % 176, d0 = 32 * nb, s0 = ((d0 >> 7) & 1) * DFF + (d0 >> 8) * 128 + (d0 & 127);
            transpose_item(A->in[15] + (size_t)l * DM * NFI, NFI, s0, 64 * kb, DM, wl + WL_FI / 2, d0, scr, lane); continue; }
        r -= I_FI;
        { const int kb = r / 32, nb = r % 32;
            transpose_item(A->in[16] + (size_t)l * DFF * DM, DM, 32 * nb, 64 * kb, DFF, wl + WL_FO / 2, 32 * nb, scr, lane); }
    }
    { float* wba = (float*)(A->ws + WS_WBA);
      for (int i = bid * NTHREADS + tid; i < DEPTH * 8 * DM; i += G * NTHREADS) { const int l = i >> 13, c = (i >> 10) & 7, k = i & 1023;
          wba[i] = A->in[6][((size_t)l * DM + k) * NPROJ_SRC + 2048 + c]; } }
    { bf16* XB = (bf16*)(A->ws + WS_XB);
      for (int m = gw; m < TT; m += NGW) {
          const float* src = m < TP ? A->in[0] + (size_t)m * DM : A->in[1] + (size_t)(m - TP) * DM;
          const f32x4* xr = (const f32x4*)src + lane; v2u* o8 = (v2u*)(XB + (size_t)m * DM) + lane;
#pragma unroll
          for (int j = 0; j < 4; ++j) { const f32x4 v = xr[64 * j]; v2u w; w.x = pk2(v.x, v.y); w.y = pk2(v.z, v.w); o8[64 * j] = w; } } }
}

__device__ __forceinline__ void ph_baconv(KA A, int l, LAS unsigned char* lds, int bid, int G, int tid) {
    asm volatile("" : "+v"(tid));
    const int wave = __builtin_amdgcn_readfirstlane(tid >> 6), lane = tid & 63;
    LAS float* wl = (LAS float*)lds;
    { const f32x4* wba = (const f32x4*)((const float*)(A->ws + WS_WBA) + (size_t)l * 8192);
      for (int i = tid; i < 2048; i += NTHREADS) ((LAS f32x4*)wl)[i] = wba[i]; }
    __syncthreads();
    const bf16* XB = (const bf16*)(A->ws + WS_XB); const bf16* PROJ = (const bf16*)(A->ws + WS_PROJ);
    float* QKV = (float*)(A->ws + WS_QKV); float* BG = (float*)(A->ws + WS_BG);
    const float* convw = A->in[7] + (size_t)l * 4 * CONVD;
    const int h = lane >> 4, d8 = (lane & 15) * 8;
    for (int row = bid * NWAVES + wave; row < TT; row += G * NWAVES) {
        { const v4u x0 = *(const v4u*)(XB + (size_t)row * DM + lane * 8), x1 = *(const v4u*)(XB + (size_t)row * DM + 512 + lane * 8);
          float xf[16]; unpack8(x0, xf); unpack8(x1, xf + 8);
          float mine = 0.f;
#pragma unroll
          for (int c = 0; c < 8; ++c) { float acc = 0.f;
#pragma unroll
              for (int j = 0; j < 8; ++j) acc += xf[j] * wl[c * 1024 + lane * 8 + j];
#pragma unroll
              for (int j = 0; j < 8; ++j) acc += xf[8 + j] * wl[c * 1024 + 512 + lane * 8 + j];
              acc = wave_sum(acc); if (lane == c) mine = acc; }
          if (lane < 8) { float o;
              if (lane < 4) o = 1.0f / (1.0f + __expf(-mine));
              else { const int hh = lane - 4; float sp = mine + A->in[9][l * 4 + hh]; sp = sp > 20.f ? sp : log1pf(__expf(sp)); o = -__expf(A->in[8][l * 4 + hh]) * sp; }
              BG[(size_t)row * 8 + lane] = o; } }
        const bool isP = row < TP; const int pos = isP ? (row % SEQ) : ((row - TP) % DECS); const int bs = isP ? (row / SEQ) : ((row - TP) / DECS);
#pragma unroll
        for (int sec = 0; sec < 3; ++sec) { const int c0 = sec * 512 + h * 128 + d8;
            float y[8], xlast[8];
#pragma unroll
            for (int j = 0; j < 8; ++j) { y[j] = 0.f; xlast[j] = 0.f; }
#pragma unroll
            for (int jj = 0; jj < 4; ++jj) { const int tp = pos - 3 + jj; float xv[8];
                if (tp >= 0) { const v4u w = *(const v4u*)(PROJ + (size_t)(row - 3 + jj) * NPROJ + c0); unpack8(w, xv); }
                else if (isP) {
#pragma unroll
                    for (int j = 0; j < 8; ++j) xv[j] = 0.f; }
                else { const float* sc = A->in[3] + (((size_t)l * DECB + bs) * 3 + (tp + 3)) * CONVD + c0; const f32x4 a0 = *(const f32x4*)sc, a1 = *(const f32x4*)(sc + 4);
                    xv[0] = a0.x; xv[1] = a0.y; xv[2] = a0.z; xv[3] = a0.w; xv[4] = a1.x; xv[5] = a1.y; xv[6] = a1.z; xv[7] = a1.w; }
                const f32x4 w0 = *(const f32x4*)(convw + jj * CONVD + c0), w1 = *(const f32x4*)(convw + jj * CONVD + c0 + 4);
                y[0] += w0.x * xv[0]; y[1] += w0.y * xv[1]; y[2] += w0.z * xv[2]; y[3] += w0.w * xv[3]; y[4] += w1.x * xv[4]; y[5] += w1.y * xv[5]; y[6] += w1.z * xv[6]; y[7] += w1.w * xv[7];
                if (jj == 3) {
#pragma unroll
                    for (int j = 0; j < 8; ++j) xlast[j] = xv[j]; } }
#pragma unroll
            for (int j = 0; j < 8; ++j) y[j] = siluf(y[j]);
            if (sec < 2) { float ss = 0.f;
#pragma unroll
                for (int j = 0; j < 8; ++j) ss += y[j] * y[j];
                ss += __shfl_xor(ss, 1); ss += __shfl_xor(ss, 2); ss += __shfl_xor(ss, 4); ss += __shfl_xor(ss, 8);
                const float rs = (1.0f / sqrtf(ss + EPS)) * (sec == 0 ? 0.08838834764831845f : 1.0f);
#pragma unroll
                for (int j = 0; j < 8; ++j) y[j] *= rs; }
            float* qd = QKV + (size_t)row * CONVD + c0;
            *(f32x4*)qd = (f32x4){y[0], y[1], y[2], y[3]}; *(f32x4*)(qd + 4) = (f32x4){y[4], y[5], y[6], y[7]};
            float* cd = nullptr;
            if (isP) { if (pos >= SEQ - 3) cd = A->out + O_CP + (((size_t)l * BATCH + bs) * 3 + (pos - (SEQ - 3))) * CONVD + c0; }
            else { if (pos >= 1) cd = A->out + O_CS + (((size_t)l * DECB + bs) * 3 + (pos - 1)) * CONVD + c0; }
            if (cd) { *(f32x4*)cd = (f32x4){xlast[0], xlast[1], xlast[2], xlast[3]}; *(f32x4*)(cd + 4) = (f32x4){xlast[4], xlast[5], xlast[6], xlast[7]}; }
        }
    }
    __syncthreads();
}

__device__ __forceinline__ void delta_naive_unit(KA A, int l, int u, LAS unsigned char* lds, int tid) {
    asm volatile("" : "+v"(tid));
    LAS float* stage = (LAS float*)lds;
    LAS float* part0 = stage + 2 * 392;
    LAS float* part1 = part0 + 512;
    const int dv = tid & 127, grp = tid >> 7, dk0 = grp * 32;
    const bool isP = u < 32; const int uu = isP ? u : u - 32; const int b = uu >> 2, h = uu & 3; const int L = isP ? SEQ : DECS;
    const size_t row0 = isP ? (size_t)b * SEQ : (size_t)TP + (size_t)b * DECS;
    const float* QKV = (const float*)(A->ws + WS_QKV); const float* BG = (const float*)(A->ws + WS_BG); float* OA = (float*)(A->ws + WS_OA);
    float S[32];
    if (isP) {
#pragma unroll
        for (int i = 0; i < 32; ++i) S[i] = 0.f; }
    else { const float* s0 = A->in[2] + ((((size_t)l * DECB + b) * HA + h) * DKA) * DVA;
#pragma unroll
        for (int i = 0; i < 32; ++i) S[i] = s0[(size_t)(dk0 + i) * DVA + dv]; }
#define DN_PREFETCH(t_, buf_) do { const size_t r_ = row0 + (t_); LAS float* s_ = stage + (buf_) * 392; \
        if (tid < 384) s_[tid] = QKV[r_ * CONVD + (tid >> 7) * 512 + h * 128 + (tid & 127)]; \
        else if (tid == 384) s_[384] = __expf(BG[r_ * 8 + 4 + h]); else if (tid == 385) s_[385] = BG[r_ * 8 + h]; } while (0)
    DN_PREFETCH(0, 0);
    __syncthreads();
    for (int t = 0; t < L; ++t) {
        const int cur = t & 1; const LAS float* st = stage + cur * 392;
        if (t + 1 < L) DN_PREFETCH(t + 1, cur ^ 1);
        const float a = st[384], be = st[385], v = st[256 + dv];
        float kk[32], qq[32];
#pragma unroll
        for (int i = 0; i < 32; ++i) { kk[i] = st[128 + dk0 + i]; qq[i] = st[dk0 + i]; }
        float pk = 0.f;
#pragma unroll
        for (int i = 0; i < 32; ++i) pk += kk[i] * S[i];
        part0[grp * 128 + dv] = pk;
        __syncthreads();
        const float kS = (part0[dv] + part0[128 + dv]) + (part0[256 + dv] + part0[384 + dv]);
        const float dl = be * (v - a * kS);
        float po = 0.f;
#pragma unroll
        for (int i = 0; i < 32; ++i) { S[i] = a * S[i] + kk[i] * dl; po += qq[i] * S[i]; }
        part1[grp * 128 + dv] = po;
        __syncthreads();
        if (grp == 0) OA[(row0 + t) * 512 + h * 128 + dv] = (part1[dv] + part1[128 + dv]) + (part1[256 + dv] + part1[384 + dv]);
    }
#undef DN_PREFETCH
    __syncthreads();
    float* dst = (isP ? A->out + O_DP + (((size_t)l * BATCH + b) * HA + h) * DKA * DVA : A->out + O_DS + (((size_t)l * DECB + b) * HA + h) * DKA * DVA);
#pragma unroll
    for (int i = 0; i < 32; ++i) dst[(size_t)(dk0 + i) * DVA + dv] = S[i];
}

__device__ __forceinline__ void swa_naive_unit(KA A, int l, int row, int hq, int lane) {
    const int kvh = hq >> 2;
    const bf16* PROJ = (const bf16*)(A->ws + WS_PROJ); bf16* MIXED = (bf16*)(A->ws + WS_MIXED);
    float q[64];
    { const v4u* qp = (const v4u*)(PROJ + (size_t)row * NPROJ + C_QB + hq * 64);
#pragma unroll
      for (int i = 0; i < 8; ++i) unpack8(qp[i], q + 8 * i); }
    const bool isP = row < TP; const int pos = isP ? (row % SEQ) : ((row - TP) % DECS); const int bs = isP ? (row / SEQ) : ((row - TP) / DECS);
    const float* ck = A->in[4] + ((size_t)l * DECB + bs) * WIN * HKVB * HDB; const float* cv = A->in[5] + ((size_t)l * DECB + bs) * WIN * HKVB * HDB;
    float sc[2];
#pragma unroll
    for (int ks = 0; ks < 2; ++ks) { const int jj = lane + 64 * ks; float s = -INFINITY;
        const bf16* kp = nullptr; const float* kf = nullptr;
        if (isP) { if (pos - 127 + jj >= 0) kp = PROJ + (size_t)(row - 127 + jj) * NPROJ + C_KB + kvh * 64; }
        else { const int e = pos + 1 + jj; if (e < WIN) kf = ck + ((size_t)e * HKVB + kvh) * HDB; else kp = PROJ + (size_t)(TP + bs * DECS + (e - WIN)) * NPROJ + C_KB + kvh * 64; }
        if (kp) { float d = 0.f;
#pragma unroll
            for (int i = 0; i < 8; ++i) { float kx[8]; unpack8(((const v4u*)kp)[i], kx);
#pragma unroll
                for (int j = 0; j < 8; ++j) d += q[8 * i + j] * kx[j]; }
            s = d * 0.125f; }
        else if (kf) { float d = 0.f;
#pragma unroll
            for (int i = 0; i < 16; ++i) { const f32x4 kx = ((const f32x4*)kf)[i]; d += q[4 * i] * kx.x + q[4 * i + 1] * kx.y + q[4 * i + 2] * kx.z + q[4 * i + 3] * kx.w; }
            s = d * 0.125f; }
        sc[ks] = s; }
    const float sink = A->in[11][l * HQB + hq];
    const float m = fmaxf(wave_max(fmaxf(sc[0], sc[1])), sink);
    const float p0 = __expf(sc[0] - m), p1 = __expf(sc[1] - m);
    const float denom = wave_sum(p0 + p1) + __expf(sink - m);
    float o = 0.f;
#pragma unroll 8
    for (int jj = 0; jj < 128; ++jj) { const float pj = __shfl(jj < 64 ? p0 : p1, jj & 63); float vv = 0.f;
        if (isP) { if (pos - 127 + jj >= 0) vv = bf2f(PROJ[(size_t)(row - 127 + jj) * NPROJ + C_VB + kvh * 64 + lane]); }
        else { const int e = pos + 1 + jj; if (e < WIN) vv = cv[((size_t)e * HKVB + kvh) * HDB + lane]; else vv = bf2f(PROJ[(size_t)(TP + bs * DECS + (e - WIN)) * NPROJ + C_VB + kvh * 64 + lane]); }
        o += pj * vv; }
    MIXED[(size_t)row * DM + 512 + hq * 64 + lane] = (bf16)f2bf(o / denom);
}

__device__ __forceinline__ void cache_out(KA A, int l, int bid, int G, int tid) {
    asm volatile("" : "+v"(tid));
    const bf16* PROJ = (const bf16*)(A->ws + WS_PROJ);
    const int gt = bid * NTHREADS + tid, NT = G * NTHREADS;
    for (int i = gt; i < BATCH * WIN * 256; i += NT) { const int c = i & 255, j = (i >> 8) & 127, b = i >> 15;
        const float val = bf2f(PROJ[(size_t)(b * SEQ + SEQ - WIN + j) * NPROJ + C_KB + c]);
        const size_t o = (((size_t)l * BATCH + b) * WIN + j) * 128;
        if (c < 128) A->out[O_KP + o + c] = val; else A->out[O_VP + o + (c - 128)] = val; }
    for (int i = gt; i < DECB * WIN * 64; i += NT) { const int c4 = i & 31, kv = (i >> 5) & 1, j = (i >> 6) & 127, b = i >> 13;
        f32x4 val;
        if (j < WIN - DECS) { const float* src = (kv ? A->in[5] : A->in[4]) + (((size_t)l * DECB + b) * WIN + (j + DECS)) * 128 + c4 * 4; val = *(const f32x4*)src; }
        else { const bf16* src = PROJ + (size_t)(TP + b * DECS + (j - (WIN - DECS))) * NPROJ + (kv ? C_VB : C_KB) + c4 * 4; const v2u w = *(const v2u*)src; val = (f32x4){bflo(w.x), bfhi(w.x), bflo(w.y), bfhi(w.y)}; }
        *(f32x4*)(A->out + (kv ? O_VS : O_KS) + (((size_t)l * DECB + b) * WIN + j) * 128 + c4 * 4) = val; }
}

__device__ __forceinline__ void ph_mix_naive(KA A, int l, LAS unsigned char* lds, int bid, int G, int tid) {
    asm volatile("" : "+v"(tid));
    const int wave = __builtin_amdgcn_readfirstlane(tid >> 6), lane = tid & 63;
    for (int u = bid; u < 32 + DECB * HA; u += G) delta_naive_unit(A, l, u, lds, tid);
    for (int u = bid * NWAVES + wave; u < TT * HQB; u += G * NWAVES) swa_naive_unit(A, l, u >> 3, u & 7, lane);
    cache_out(A, l, bid, G, tid);
}

__device__ __forceinline__ void ph_gate(KA A, int l, int bid, int G, int tid) {
    asm volatile("" : "+v"(tid));
    const int wave = __builtin_amdgcn_readfirstlane(tid >> 6), lane = tid & 63; const int h = lane >> 4, d8 = (lane & 15) * 8;
    const float* OA = (const float*)(A->ws + WS_OA); const bf16* PROJ = (const bf16*)(A->ws + WS_PROJ); bf16* MIXED = (bf16*)(A->ws + WS_MIXED);
    const float* nw = A->in[10] + l * DVA + d8; const f32x4 n0 = *(const f32x4*)nw, n1 = *(const f32x4*)(nw + 4);
    const float nwv[8] = {n0.x, n0.y, n0.z, n0.w, n1.x, n1.y, n1.z, n1.w};
    for (int row = bid * NWAVES + wave; row < TT; row += G * NWAVES) {
        const float* op = OA + (size_t)row * 512 + h * 128 + d8; const f32x4 a0 = *(const f32x4*)op, a1 = *(const f32x4*)(op + 4);
        float o[8] = {a0.x, a0.y, a0.z, a0.w, a1.x, a1.y, a1.z, a1.w};
        float ss = 0.f;
#pragma unroll
        for (int j = 0; j < 8; ++j) ss += o[j] * o[j];
        ss += __shfl_xor(ss, 1); ss += __shfl_xor(ss, 2); ss += __shfl_xor(ss, 4); ss += __shfl_xor(ss, 8);
        const float rs = 1.0f / sqrtf(ss * (1.0f / 128.0f) + EPS);
        float z[8]; unpack8(*(const v4u*)(PROJ + (size_t)row * NPROJ + C_ZA + h * 128 + d8), z);
        float r[8];
#pragma unroll
        for (int j = 0; j < 8; ++j) r[j] = o[j] * rs * nwv[j] * siluf(z[j]);
        v4u w; w.x = pk2(r[0], r[1]); w.y = pk2(r[2], r[3]); w.z = pk2(r[4], r[5]); w.w = pk2(r[6], r[7]);
        *(v4u*)(MIXED + (size_t)row * DM + h * 128 + d8) = w;
    }
}

__device__ __forceinline__ void ph_ln(KA A, const float* gam, const float* bet, int bid, int G, int tid) {
    asm volatile("" : "+v"(tid));
    const int wave = __builtin_amdgcn_readfirstlane(tid >> 6), lane = tid & 63;
    const float* Y = (const float*)(A->ws + WS_Y); bf16* XB = (bf16*)(A->ws + WS_XB);
    for (int row = bid * NWAVES + wave; row < TT; row += G * NWAVES) {
        const f32x4* y = (const f32x4*)(Y + (size_t)row * DM) + lane; f32x4 v[4]; float s = 0.f;
#pragma unroll
        for (int j = 0; j < 4; ++j) { v[j] = y[64 * j]; s += (v[j].x + v[j].y) + (v[j].z + v[j].w); }
        const float mean = wave_sum(s) * (1.0f / DM); float s2 = 0.f;
#pragma unroll
        for (int j = 0; j < 4; ++j) { v[j] = v[j] - mean; s2 += (v[j].x * v[j].x + v[j].y * v[j].y) + (v[j].z * v[j].z + v[j].w * v[j].w); }
        const float rstd = 1.0f / sqrtf(wave_sum(s2) * (1.0f / DM) + EPS);
        f32x4* xo = (f32x4*)(A->out + (size_t)row * DM) + lane; v2u* xb = (v2u*)(XB + (size_t)row * DM) + lane;
#pragma unroll
        for (int j = 0; j < 4; ++j) { const f32x4 g = ((const f32x4*)gam)[lane + 64 * j], bb = ((const f32x4*)bet)[lane + 64 * j];
            const f32x4 o = v[j] * rstd * g + bb; xo[64 * j] = o; v2u w; w.x = pk2(o.x, o.y); w.y = pk2(o.z, o.w); xb[64 * j] = w; }
    }
}
typedef short bf16x8 __attribute__((ext_vector_type(8)));
typedef short v4i16_t __attribute__((ext_vector_type(4)));
__device__ __forceinline__ unsigned cvtpk(float lo, float hi) { unsigned r; asm("v_cvt_pk_bf16_f32 %0, %1, %2" : "=v"(r) : "v"(lo), "v"(hi)); return r; }
__device__ __forceinline__ v4u pack8u(const f32x4 a, const f32x4 b) { v4u w; w.x = cvtpk(a.x, a.y); w.y = cvtpk(a.z, a.w); w.z = cvtpk(b.x, b.y); w.w = cvtpk(b.z, b.w); return w; }
__device__ __forceinline__ bf16x8 pack8(const f32x4 a, const f32x4 b) { return __builtin_bit_cast(bf16x8, pack8u(a, b)); }
#define MFMA16(a_, b_, c_) __builtin_amdgcn_mfma_f32_16x16x32_bf16((a_), (b_), (c_), 0, 0, 0)

__device__ __forceinline__ void prep_unit(KA A, int u, LAS unsigned char* wl, int lane) {
    asm volatile("" : "+v"(lane));
    const int h = u & 3, n = (u >> 2) & 31, b = u >> 7;
    const int lr = lane & 15, lg = lane >> 4;
    const size_t row0 = (size_t)b * SEQ + (size_t)n * 64;
    const float* BG = (const float*)(A->ws + WS_BG);
    const float* qp = (const float*)(A->ws + WS_QKV) + row0 * CONVD + h * 128; const float* kp = qp + 512;
    unsigned char* CH = A->ws + WS_CH + (size_t)((b * 4 + h) * 32 + n) * 65536;
    const float bj = BG[(row0 + lane) * 8 + h];
    float gc = BG[(row0 + lane) * 8 + 4 + h];
#pragma unroll
    for (int d = 1; d < 64; d <<= 1) { const float t = __shfl_up(gc, d); if (lane >= d) gc += t; }
    const float gcl = __shfl(gc, 63);
    bf16x8 Kf[4][4];
#pragma unroll
    for (int mt = 0; mt < 4; ++mt)
#pragma unroll
        for (int ks = 0; ks < 4; ++ks) { const float* p = kp + (size_t)(16 * mt + lr) * CONVD + 32 * ks + 8 * lg; Kf[mt][ks] = pack8(*(const f32x4*)p, *(const f32x4*)(p + 4)); }
    LAS float* AT = (LAS float*)wl;
#pragma unroll
    for (int mi = 0; mi < 4; ++mi)
#pragma unroll
        for (int ni = 0; ni <= mi; ++ni) {
            f32x4 c = {0.f, 0.f, 0.f, 0.f};
#pragma unroll
            for (int ks = 0; ks < 4; ++ks) c = MFMA16(Kf[mi][ks], Kf[ni][ks], c);
            const int j = 16 * ni + lr; const float gcj = __shfl(gc, j);
            f32x4 o;
#pragma unroll
            for (int r = 0; r < 4; ++r) { const int i = 16 * mi + 4 * lg + r; const float gi = __shfl(gc, i), bi = __shfl(bj, i);
                o[r] = (i > j) ? bi * c[r] * __expf(fminf(gi - gcj, 0.f)) : 0.f; }
            *(LAS f32x4*)(AT + j * 64 + 16 * mi + 4 * lg) = o;
        }
    asm volatile("" ::: "memory");
#pragma unroll
    for (int mi = 0; mi < 4; ++mi) {
        bf16x8 Qf[4];
#pragma unroll
        for (int ks = 0; ks < 4; ++ks) { const float* p = qp + (size_t)(16 * mi + lr) * CONVD + 32 * ks + 8 * lg; Qf[ks] = pack8(*(const f32x4*)p, *(const f32x4*)(p + 4)); }
        const int i = 16 * mi + lr; const float gi = __shfl(gc, i);
        f32x4 t[4];
#pragma unroll
        for (int nj = 0; nj < 4; ++nj) {
            f32x4 c = {0.f, 0.f, 0.f, 0.f};
            if (nj <= mi) {
#pragma unroll
                for (int ks = 0; ks < 4; ++ks) c = MFMA16(Kf[nj][ks], Qf[ks], c);
#pragma unroll
                for (int r = 0; r < 4; ++r) { const int j = 16 * nj + 4 * lg + r; const float gj = __shfl(gc, j); c[r] = (i >= j) ? c[r] * __expf(fminf(gi - gj, 0.f)) : 0.f; }
            }
            t[nj] = c;
        }
#pragma unroll
        for (int ks2 = 0; ks2 < 2; ++ks2) *(v4u*)(CH + 57344 + ((mi * 2 + ks2) * 64 + lane) * 16) = pack8u(t[2 * ks2], t[2 * ks2 + 1]);
    }
    asm volatile("" ::: "memory");
    LAS float* Tl = (LAS float*)(wl + 16384);
    for (int j = 0; j < 64; ++j) Tl[j * 64 + lane] = 0.f;
    for (int j = 63; j >= 0; --j) {
        float a0 = 0.f, a1 = 0.f, a2 = 0.f, a3 = 0.f;
        for (int i = ((j + 1) >> 2) << 2; i < 64; i += 4) { const f32x4 a = *(const LAS f32x4*)(AT + j * 64 + i);
            a0 += Tl[i * 64 + lane] * a.x; a1 += Tl[(i + 1) * 64 + lane] * a.y; a2 += Tl[(i + 2) * 64 + lane] * a.z; a3 += Tl[(i + 3) * 64 + lane] * a.w; }
        Tl[j * 64 + lane] = (lane == j) ? 1.0f : -((a0 + a1) + (a2 + a3));
    }
    asm volatile("s_waitcnt lgkmcnt(0)" ::: "memory");
    LAS unsigned char* TR = wl;
    for (int c = 0; c < 8; ++c) { float tv[8];
#pragma unroll
        for (int e = 0; e < 8; ++e) tv[e] = Tl[(8 * c + e) * 64 + lane] * __shfl(bj, 8 * c + e);
        v4u w; w.x = cvtpk(tv[0], tv[1]); w.y = cvtpk(tv[2], tv[3]); w.z = cvtpk(tv[4], tv[5]); w.w = cvtpk(tv[6], tv[7]);
        *(LAS v4u*)(TR + lane * 144 + c * 16) = w; }
    asm volatile("s_waitcnt lgkmcnt(0)" ::: "memory");
#pragma unroll
    for (int mi = 0; mi < 4; ++mi)
#pragma unroll
        for (int ks2 = 0; ks2 < 2; ++ks2) { const LAS unsigned char* rp = TR + (16 * mi + lr) * 144;
            const v2u lo = *(const LAS v2u*)(rp + (32 * ks2 + 4 * lg) * 2), hi = *(const LAS v2u*)(rp + (32 * ks2 + 16 + 4 * lg) * 2);
            v4u w; w.x = lo.x; w.y = lo.y; w.z = hi.x; w.w = hi.y;
            *(v4u*)(CH + 49152 + ((mi * 2 + ks2) * 64 + lane) * 16) = w; }
    asm volatile("" ::: "memory");
#pragma unroll
    for (int mi = 0; mi < 4; ++mi) { const int tok = 16 * mi + lr; const float e = __expf(__shfl(gc, tok));
        asm volatile("" ::: "memory");
#pragma unroll
        for (int ks = 0; ks < 4; ++ks) { const float* p = kp + (size_t)tok * CONVD + 32 * ks + 4 * lg; const float* pq = qp + (size_t)tok * CONVD + 32 * ks + 4 * lg;
            *(v4u*)(CH + ((mi * 4 + ks) * 64 + lane) * 16) = pack8u(*(const f32x4*)p * e, *(const f32x4*)(p + 16) * e);
            *(v4u*)(CH + 16384 + ((mi * 4 + ks) * 64 + lane) * 16) = pack8u(*(const f32x4*)pq * e, *(const f32x4*)(pq + 16) * e); } }
    asm volatile("s_waitcnt lgkmcnt(0)" ::: "memory");
    LAS unsigned char* KD = wl;
#pragma unroll
    for (int mt = 0; mt < 4; ++mt) { const int tok = 16 * mt + lr; const float e = __expf(gcl - __shfl(gc, tok));
        asm volatile("" ::: "memory");
#pragma unroll
        for (int ks = 0; ks < 4; ++ks) { const float* p = kp + (size_t)tok * CONVD + 32 * ks + 8 * lg;
            *(LAS v4u*)(KD + tok * 256 + (32 * ks + 8 * lg) * 2) = pack8u(*(const f32x4*)p * e, *(const f32x4*)(p + 4) * e); } }
    asm volatile("s_waitcnt lgkmcnt(0)" ::: "memory");
    { const int q4 = lr >> 2, p4 = lr & 3;
#pragma unroll
      for (int mi = 0; mi < 8; ++mi)
#pragma unroll
        for (int ks2 = 0; ks2 < 2; ++ks2) {
            const v4i16_t lo = __builtin_amdgcn_ds_read_tr16_b64_v4i16((LAS v4i16_t*)(KD + (32 * ks2 + 4 * lg + q4) * 256 + (16 * mi + 4 * p4) * 2));
            const v4i16_t hi = __builtin_amdgcn_ds_read_tr16_b64_v4i16((LAS v4i16_t*)(KD + (32 * ks2 + 16 + 4 * lg + q4) * 256 + (16 * mi + 4 * p4) * 2));
            const v2u l2 = __builtin_bit_cast(v2u, lo), h2 = __builtin_bit_cast(v2u, hi);
            v4u w; w.x = l2.x; w.y = l2.y; w.z = h2.x; w.w = h2.y;
            *(v4u*)(CH + 32768 + ((mi * 2 + ks2) * 64 + lane) * 16) = w; } }
    if (lane == 0) ((float*)(A->ws + WS_GL))[(b * 4 + h) * 32 + n] = __expf(gcl);
    asm volatile("s_waitcnt lgkmcnt(0)" ::: "memory");
}
__device__ __forceinline__ void ph_prep(KA A, LAS unsigned char* lds, int bid, int G, int tid) {
    asm volatile("" : "+v"(tid));
    const int wave = __builtin_amdgcn_readfirstlane(tid >> 6), lane = tid & 63;
    for (int u = wave * G + bid; u < BATCH * 32 * HA; u += 4 * G) { if (wave < 4) prep_unit(A, u, lds + wave * 32768, lane); }
}

__device__ __forceinline__ void scan_unit(KA A, int l, int bh, LAS unsigned char* lds, int tid) {
    const int w = __builtin_amdgcn_readfirstlane(tid >> 6), lane = tid & 63, lr = lane & 15, lg = lane >> 4;
    const int b = bh >> 2, h = bh & 3;
    const unsigned char* CHb = A->ws + WS_CH + (size_t)bh * 32 * 65536;
    const float* vp = (const float*)(A->ws + WS_QKV) + (size_t)b * SEQ * CONVD + 1024 + h * 128 + 16 * w + lr;
    float* OA = (float*)(A->ws + WS_OA) + (size_t)b * SEQ * 512 + h * 128 + 16 * w + lr;
    const float* GL = (const float*)(A->ws + WS_GL) + bh * 32;
    f32x4 S[8];
#pragma unroll
    for (int i = 0; i < 8; ++i) S[i] = (f32x4){0.f, 0.f, 0.f, 0.f};
#define SC_STAGE(n_, bo_) do { _Pragma("unroll") for (int i_ = 0; i_ < 8; ++i_) \
        __builtin_amdgcn_global_load_lds((const unsigned*)(CHb + (size_t)(n_) * 65536 + (w * 8 + i_) * 1024 + lane * 16), (LAS unsigned*)(lds + (bo_) + (w * 8 + i_) * 1024), 16, 0, 0); } while (0)
#define SC_FR(off_, idx_) (*(const LAS bf16x8*)(fb + (off_) + (idx_) * 1024))
    SC_STAGE(0, 0);
    for (int n = 0; n < 32; ++n) {
        asm volatile("s_waitcnt vmcnt(0)" ::: "memory");
        __syncthreads();
        const int bo = (n & 1) * 65536;
        if (n + 1 < 32) SC_STAGE(n + 1, bo ^ 65536);
        f32x4 Vc[4];
#pragma unroll
        for (int mi = 0; mi < 4; ++mi)
#pragma unroll
            for (int r = 0; r < 4; ++r) Vc[mi][r] = vp[(size_t)(64 * n + 16 * mi + 4 * lg + r) * CONVD];
        const float gl = GL[n];
        bf16x8 Sb[4];
#pragma unroll
        for (int ks = 0; ks < 4; ++ks) Sb[ks] = pack8(S[2 * ks], S[2 * ks + 1]);
        const LAS unsigned char* fb = lds + bo + lane * 16;
        f32x4 R[4];
#pragma unroll
        for (int mi = 0; mi < 4; ++mi) { f32x4 c = {0.f, 0.f, 0.f, 0.f};
#pragma unroll
            for (int ks = 0; ks < 4; ++ks) c = MFMA16(SC_FR(0, mi * 4 + ks), Sb[ks], c);
            R[mi] = Vc[mi] - c; }
        bf16x8 Rb[2]; Rb[0] = pack8(R[0], R[1]); Rb[1] = pack8(R[2], R[3]);
        f32x4 vn[4];
#pragma unroll
        for (int mi = 0; mi < 4; ++mi) { f32x4 c = {0.f, 0.f, 0.f, 0.f};
#pragma unroll
            for (int ks2 = 0; ks2 < 2; ++ks2) c = MFMA16(SC_FR(49152, mi * 2 + ks2), Rb[ks2], c);
            vn[mi] = c; }
        bf16x8 Vb[2]; Vb[0] = pack8(vn[0], vn[1]); Vb[1] = pack8(vn[2], vn[3]);
#pragma unroll
        for (int mi = 0; mi < 4; ++mi) { f32x4 c = {0.f, 0.f, 0.f, 0.f};
#pragma unroll
            for (int ks = 0; ks < 4; ++ks) c = MFMA16(SC_FR(16384, mi * 4 + ks), Sb[ks], c);
#pragma unroll
            for (int ks2 = 0; ks2 < 2; ++ks2) c = MFMA16(SC_FR(57344, mi * 2 + ks2), Vb[ks2], c);
#pragma unroll
            for (int r = 0; r < 4; ++r) OA[(size_t)(64 * n + 16 * mi + 4 * lg + r) * 512] = c[r]; }
#pragma unroll
        for (int mi = 0; mi < 8; ++mi) { f32x4 c = S[mi] * gl;
#pragma unroll
            for (int ks2 = 0; ks2 < 2; ++ks2) c = MFMA16(SC_FR(32768, mi * 2 + ks2), Vb[ks2], c);
            S[mi] = c; }
    }
#undef SC_STAGE
#undef SC_FR
    float* dst = A->out + O_DP + ((size_t)(l * BATCH + b) * HA + h) * DKA * DVA + 16 * w + lr;
#pragma unroll
    for (int mi = 0; mi < 8; ++mi)
#pragma unroll
        for (int r = 0; r < 4; ++r) dst[(size_t)(16 * mi + 4 * lg + r) * DVA] = S[mi][r];
    __syncthreads();
}
constexpr int SWA_VSTRIDE = 144;
__device__ __forceinline__ void swa_unit(KA A, int l, int u, LAS unsigned char* lds, int tid) {
    const int w = __builtin_amdgcn_readfirstlane(tid >> 6), lane = tid & 63, lr = lane & 15, lg = lane >> 4;
    const int qb = u & 31, kvh = (u >> 5) & 1, b = u >> 6;
    const int t0 = qb * 64, kbase = t0 - 128;
    const bf16* PROJ = (const bf16*)(A->ws + WS_PROJ) + (size_t)b * SEQ * NPROJ; bf16* MIXED = (bf16*)(A->ws + WS_MIXED) + (size_t)b * SEQ * DM;
#pragma unroll
    for (int p = 0; p < 3; ++p) { const int idx = p * NTHREADS + tid, row = idx >> 3, ch = idx & 7, tok = kbase + row;
        v4u v = {0u, 0u, 0u, 0u};
        if (tok >= 0) v = *(const v4u*)(PROJ + (size_t)tok * NPROJ + C_VB + kvh * 64 + ch * 8);
        *(LAS v4u*)(lds + row * SWA_VSTRIDE + ch * 16) = v; }
    __syncthreads();
    const int g4 = w >> 1, th = w & 1, hq = kvh * 4 + g4;
    const int tq0 = t0 + 32 * th;
    bf16x8 Qf[2][2];
#pragma unroll
    for (int mt = 0; mt < 2; ++mt)
#pragma unroll
        for (int ks = 0; ks < 2; ++ks) Qf[mt][ks] = *(const bf16x8*)(PROJ + (size_t)(tq0 + 16 * mt + lr) * NPROJ + C_QB + hq * 64 + 32 * ks + 8 * lg);
    f32x4 P[2][10];
#pragma unroll
    for (int kk = 0; kk < 10; ++kk) { const int ktok = kbase + 16 * (2 * th + kk) + lr;
        bf16x8 Kf0 = {0, 0, 0, 0, 0, 0, 0, 0}, Kf1 = {0, 0, 0, 0, 0, 0, 0, 0};
        if (ktok >= 0) { const bf16* kp = PROJ + (size_t)ktok * NPROJ + C_KB + kvh * 64 + 8 * lg; Kf0 = *(const bf16x8*)kp; Kf1 = *(const bf16x8*)(kp + 32); }
#pragma unroll
        for (int mt = 0; mt < 2; ++mt) { f32x4 c = {0.f, 0.f, 0.f, 0.f}; c = MFMA16(Kf0, Qf[mt][0], c); c = MFMA16(Kf1, Qf[mt][1], c);
            const int qtok = tq0 + 16 * mt + lr;
#pragma unroll
            for (int r = 0; r < 4; ++r) { const int kt_ = kbase + 16 * (2 * th + kk) + 4 * lg + r; const bool ok = (kt_ <= qtok) && (kt_ > qtok - WIN) && (kt_ >= 0); c[r] = ok ? c[r] * 0.125f : -INFINITY; }
            P[mt][kk] = c; } }
    const float sink = A->in[11][l * HQB + hq];
    float rden[2];
#pragma unroll
    for (int mt = 0; mt < 2; ++mt) { float m = sink;
#pragma unroll
        for (int kk = 0; kk < 10; ++kk) m = fmaxf(fmaxf(fmaxf(m, P[mt][kk][0]), fmaxf(P[mt][kk][1], P[mt][kk][2])), P[mt][kk][3]);
        m = fmaxf(m, __shfl_xor(m, 16)); m = fmaxf(m, __shfl_xor(m, 32));
        float s = 0.f;
#pragma unroll
        for (int kk = 0; kk < 10; ++kk)
#pragma unroll
            for (int r = 0; r < 4; ++r) { const float e = __expf(P[mt][kk][r] - m); P[mt][kk][r] = e; s += e; }
        s += __shfl_xor(s, 16); s += __shfl_xor(s, 32);
        rden[mt] = 1.0f / (s + __expf(sink - m)); }
    bf16x8 Pb[2][5];
#pragma unroll
    for (int mt = 0; mt < 2; ++mt)
#pragma unroll
        for (int k2 = 0; k2 < 5; ++k2) Pb[mt][k2] = pack8(P[mt][2 * k2], P[mt][2 * k2 + 1]);
    const int q4 = lr >> 2, p4 = lr & 3;
#pragma unroll
    for (int dt = 0; dt < 4; ++dt) { f32x4 o0 = {0.f, 0.f, 0.f, 0.f}, o1 = {0.f, 0.f, 0.f, 0.f};
#pragma unroll
        for (int k2 = 0; k2 < 5; ++k2) { const int krow = 16 * (2 * th + 2 * k2) + 4 * lg + q4;
            const v4i16_t lo = __builtin_amdgcn_ds_read_tr16_b64_v4i16((LAS v4i16_t*)(lds + krow * SWA_VSTRIDE + (16 * dt + 4 * p4) * 2));
            const v4i16_t hi = __builtin_amdgcn_ds_read_tr16_b64_v4i16((LAS v4i16_t*)(lds + (krow + 16) * SWA_VSTRIDE + (16 * dt + 4 * p4) * 2));
            const v2u l2 = __builtin_bit_cast(v2u, lo), h2 = __builtin_bit_cast(v2u, hi); v4u wv; wv.x = l2.x; wv.y = l2.y; wv.z = h2.x; wv.w = h2.y;
            const bf16x8 Vf = __builtin_bit_cast(bf16x8, wv);
            o0 = MFMA16(Vf, Pb[0][k2], o0); o1 = MFMA16(Vf, Pb[1][k2], o1); }
        { const f32x4 a = o0 * rden[0]; v2u wv; wv.x = cvtpk(a.x, a.y); wv.y = cvtpk(a.z, a.w); *(v2u*)(MIXED + (size_t)(tq0 + lr) * DM + 512 + hq * 64 + 16 * dt + 4 * lg) = wv; }
        { const f32x4 a = o1 * rden[1]; v2u wv; wv.x = cvtpk(a.x, a.y); wv.y = cvtpk(a.z, a.w); *(v2u*)(MIXED + (size_t)(tq0 + 16 + lr) * DM + 512 + hq * 64 + 16 * dt + 4 * lg) = wv; } }
    __syncthreads();
}
__device__ __forceinline__ void ph_scanmix(KA A, int l, LAS unsigned char* lds, int bid, int G, int tid) {
    asm volatile("" : "+v"(tid));
    const int wave = __builtin_amdgcn_readfirstlane(tid >> 6), lane = tid & 63;
    if (bid < 32) { scan_unit(A, l, bid, lds, tid); return; }
    const int b2 = bid - 32, G2 = G - 32;
    for (int u = b2; u < BATCH * HKVB * 32; u += G2) swa_unit(A, l, u, lds, tid);
    for (int u = 32 + b2; u < 32 + DECB * HA; u += G2) delta_naive_unit(A, l, u, lds, tid);
    for (int u = b2 * NWAVES + wave; u < TS * HQB; u += G2 * NWAVES) swa_naive_unit(A, l, TP + (u >> 3), u & 7, lane);
    cache_out(A, l, b2, G2, tid);
}
constexpr int PH_PER_LAYER = 10, N_PHASES = 1 + DEPTH * PH_PER_LAYER;
__global__ void __launch_bounds__(NTHREADS, 2) fwd(Args a) {
    extern __shared__ __attribute__((aligned(16))) unsigned char lds_[];
    LAS unsigned char* lds = (LAS unsigned char*)lds_;
    const int tid = threadIdx.x, bid = blockIdx.x, G = gridDim.x;
    for (int u = tid; u < (LDS_BYTES - LDSCTL_OFF) / 4; u += NTHREADS) ((LAS unsigned*)(lds + LDSCTL_OFF))[u] = 0u;
    __syncthreads();
    gu32* ctl = (gu32*)(a.ws + WS_CTL);
    XcdBarrier bar; bar.bar = (unsigned*)(ctl + CW_BAR); bar.x = 0; bar.st = nullptr;
#if MK_ONE_LAUNCH
    bar = xcd_barrier_post((unsigned*)(ctl + CW_BAR), (volatile LAS unsigned*)(lds + MISC_OFF) + 8);
#endif
    const int ph_lo = a.ph_lo, ph_hi = a.ph_hi;
    for (int ph = ph_lo; ph < ph_hi; ++ph) {
        KA A = (KA)__builtin_amdgcn_kernarg_segment_ptr(); asm volatile("" : "+s"(A));
        bf16* XB = (bf16*)(A->ws + WS_XB); bf16* PROJ = (bf16*)(A->ws + WS_PROJ); bf16* MIXED = (bf16*)(A->ws + WS_MIXED); bf16* HB = (bf16*)(A->ws + WS_H); float* Y = (float*)(A->ws + WS_Y);
        if (ph == 0) ph_prologue(A, lds, bid, G, tid);
        else {
            const int l = (ph - 1) / PH_PER_LAYER, k = (ph - 1) % PH_PER_LAYER;
            const bf16* wl = (const bf16*)(A->ws + WS_W + (size_t)l * WL_STRIDE);
            if (k == 0) {
                pg8::Gemm g{XB, wl + WL_IN / 2, TT, NPROJ, DM}; pg8::StaticOrder S; S.init(TT, NPROJ, G, bid);
                pg8::EpiBf16<0> E{PROJ, NPROJ, nullptr, 0, 0, 1.f};
                pg8::gemm_phase<pg8::EpiBf16<0>, pg8::StaticOrder, true, true>(lds, g, S, E);
            } else if (k == 1) ph_baconv(A, l, lds, bid, G, tid);
            else if (k == 2) ph_prep(A, lds, bid, G, tid);
            else if (k == 3) ph_scanmix(A, l, lds, bid, G, tid);
            else if (k == 4) ph_gate(A, l, bid, G, tid);
            else if (k == 5) {
                pg8::Gemm g{MIXED, wl + WL_OUT / 2, TT, DM, DM}; pg8::StaticOrder S; S.init(TT, DM, G, bid);
                pg8::EpiResF32 E{Y, DM, l == 0 ? A->in[0] : A->out, l == 0 ? A->in[1] : A->out + (size_t)TP * DM, TP, ALPHA};
                pg8::gemm_phase<pg8::EpiResF32, pg8::StaticOrder, true, true>(lds, g, S, E);
            } else if (k == 6) ph_ln(A, A->in[13] + l * DM, A->in[14] + l * DM, bid, G, tid);
            else if (k == 7) {
                pg8::Gemm g{XB, wl + WL_FI / 2, TT, NFI, DM}; pg8::StaticOrder S; S.init(TT, NFI, G, bid);
                pg8::EpiSwiGLU E{HB, DFF};
                pg8::gemm_phase<pg8::EpiSwiGLU, pg8::StaticOrder, true, true>(lds, g, S, E);
            } else if (k == 8) {
                pg8::Gemm g{HB, wl + WL_FO / 2, TT, DM, DFF}; pg8::StaticOrder S; S.init(TT, DM, G, bid);
                pg8::EpiResF32 E{Y, DM, A->out, A->out + (size_t)TP * DM, TP, ALPHA};
                pg8::gemm_phase<pg8::EpiResF32, pg8::StaticOrder, true, true>(lds, g, S, E);
            } else ph_ln(A, A->in[17] + l * DM, A->in[18] + l * DM, bid, G, tid);
        }
        if (ph + 1 < ph_hi) {
#if MK_ONE_LAUNCH
            if (ph == ph_lo) { __threadfence(); cg::this_grid().sync(); } else xcd_barrier(bar);
#endif
        }
    }
}

extern "C" void kernel_launch(void* const* d_in, const int* in_sizes, int n_in, void* d_out, int out_size, void* d_ws, size_t ws_size, hipStream_t stream) {
    static int grid = 0;
    if (grid == 0) {
        if (n_in != 19 || (size_t)out_size != O_END || ws_size < WS_END) { fprintf(stderr, "kernel_launch: unexpected shapes: n_in %d out %d ws %zu\n", n_in, out_size, ws_size); grid = -1; return; }
        int dev = 0, cus = 0, per_cu = 0;
        if (hipGetDevice(&dev) != hipSuccess || hipDeviceGetAttribute(&cus, hipDeviceAttributeMultiprocessorCount, dev) != hipSuccess) { grid = -1; return; }
        if (hipFuncSetAttribute((const void*)fwd, hipFuncAttributeMaxDynamicSharedMemorySize, LDS_BYTES) != hipSuccess) { fprintf(stderr, "kernel_launch: hipFuncSetAttribute failed\n"); grid = -1; return; }
        if (hipOccupancyMaxActiveBlocksPerMultiprocessor(&per_cu, (const void*)fwd, NTHREADS, LDS_BYTES) != hipSuccess || per_cu < 1) { fprintf(stderr, "kernel_launch: occupancy query says %d\n", per_cu); per_cu = 1; }
        (void)hipGetLastError();
        grid = cus;
    }
    if (grid < 0) return;
    if (hipMemsetAsync((char*)d_ws + WS_CTL, 0, CTL_ZERO_BYTES, stream) != hipSuccess) { fprintf(stderr, "kernel_launch: memset failed\n"); return; }
    Args a{};
    for (int i = 0; i < 19; ++i) a.in[i] = (const float*)d_in[i];
    a.out = (float*)d_out; a.ws = (unsigned char*)d_ws;
#if MK_ONE_LAUNCH
    a.ph_lo = 0; a.ph_hi = N_PHASES;
    void* args[] = {&a};
    hipError_t e = hipLaunchCooperativeKernel((const void*)fwd, dim3(grid), dim3(NTHREADS), args, LDS_BYTES, stream);
    if (e != hipSuccess) fprintf(stderr, "kernel_launch: cooperative launch failed: %s (grid %d)\n", hipGetErrorString(e), grid);
#else
    for (int ph = 0; ph < N_PHASES; ++ph) { a.ph_lo = ph; a.ph_hi = ph + 1; hipLaunchKernelGGL(fwd, dim3(grid), dim3(NTHREADS), LDS_BYTES, stream, a); }
#endif
}
```
